# Optimizing an MI355X kernel written in HIP

```python
import math
import jax, jax.numpy as jnp
from jax import lax
import numpy as np

D_MODEL = 1024
BATCH = 2
SEQ = 8192
DEPTH = 1

N_HEADS = 8
HEAD_DIM = 64
ATTN_WIDTH = N_HEADS * HEAD_DIM
MOBA_BLOCK = 256
MOBA_TOPK = 3
Q_CHUNK = 128
SSM_GROUP = 16
SSM_GROUPS = 32
SSM_WIDTH = SSM_GROUP * SSM_GROUPS
SSM_STATE = 64
DT_MIN = 1e-3
DT_MAX = 1e-1
D_FF = 2816
EPS = 1e-6
IN_WIDTH = 3 * ATTN_WIDTH + SSM_WIDTH + 2 * D_MODEL
SPLIT_POINTS = (ATTN_WIDTH, 2 * ATTN_WIDTH, 3 * ATTN_WIDTH, 3 * ATTN_WIDTH + SSM_WIDTH,
                3 * ATTN_WIDTH + SSM_WIDTH + D_MODEL)

kernel_name = "hybrid_moba_s5_macaron"


def rms_norm(x, g):
    xf = x.astype(jnp.float32)
    y = xf * lax.rsqrt(jnp.mean(xf * xf, axis=-1, keepdims=True) + EPS)
    return (y * g.astype(jnp.float32)).astype(x.dtype)


def swiglu(h, w_gate, w_up, w_down):
    return (jax.nn.silu(h @ w_gate) * (h @ w_up)) @ w_down


def alibi_slopes(n_heads):
    return jnp.asarray(2.0 ** (-8.0 * np.arange(1, n_heads + 1) / n_heads), dtype=jnp.float32)


def moba_attention(q, k, v):
    B, H, S, Dh = q.shape
    nb = -(-S // MOBA_BLOCK)
    pad = nb * MOBA_BLOCK - S
    qf = q.astype(jnp.float32)
    kp = jnp.pad(k.astype(jnp.float32), ((0, 0), (0, 0), (0, pad), (0, 0)))
    vp = jnp.pad(v.astype(jnp.float32), ((0, 0), (0, 0), (0, pad), (0, 0)))
    kb = kp.reshape(B, H, nb, MOBA_BLOCK, Dh)
    vb = vp.reshape(B, H, nb, MOBA_BLOCK, Dh)
    k_mean = jnp.mean(kb, axis=3)
    gate = jnp.einsum('bhsd,bhnd->bhsn', qf, k_mean)
    own_blk = jnp.arange(S) // MOBA_BLOCK
    past = jnp.arange(nb)[None, :] < own_blk[:, None]
    gate = jnp.where(past[None, None], gate, -jnp.inf)
    k_sel = min(MOBA_TOPK, nb)
    _, sel = lax.top_k(gate, k_sel)
    scale = HEAD_DIM ** -0.5
    slopes = alibi_slopes(H)
    bi = jnp.arange(B)[:, None, None, None]
    hi = jnp.arange(H)[None, :, None, None]
    n_chunks = S // Q_CHUNK

    def chunk(c):
        t0 = c * Q_CHUNK
        qc = lax.dynamic_slice_in_dim(qf, t0, Q_CHUNK, axis=2)
        selc = lax.dynamic_slice_in_dim(sel, t0, Q_CHUNK, axis=2)
        tq = t0 + jnp.arange(Q_CHUNK)
        blk = t0 // MOBA_BLOCK
        k_own = lax.dynamic_index_in_dim(kb, blk, axis=2, keepdims=False)
        v_own = lax.dynamic_index_in_dim(vb, blk, axis=2, keepdims=False)
        s_own = blk * MOBA_BLOCK + jnp.arange(MOBA_BLOCK)
        dist_own = (tq[:, None] - s_own[None, :])
        sc_own = jnp.einsum('bhqd,bhkd->bhqk', qc, k_own) * scale
        sc_own = sc_own - slopes[:, None, None] * jnp.abs(dist_own).astype(jnp.float32)
        sc_own = jnp.where((dist_own >= 0)[None, None], sc_own, -jnp.inf)
        k_g = kb[bi, hi, selc]
        v_g = vb[bi, hi, selc]
        sc_sel = jnp.einsum('bhqd,bhqnkd->bhqnk', qc, k_g) * scale
        s_pos = selc[..., None] * MOBA_BLOCK + jnp.arange(MOBA_BLOCK)
        dist_sel = jnp.abs(tq[:, None, None] - s_pos).astype(jnp.float32)
        sc_sel = sc_sel - slopes[:, None, None, None] * dist_sel
        valid = selc < blk
        sc_sel = jnp.where(valid[..., None], sc_sel, -jnp.inf)
        scores = jnp.concatenate(
            [sc_own, sc_sel.reshape(B, H, Q_CHUNK, k_sel * MOBA_BLOCK)], axis=-1)
        p = jax.nn.softmax(scores, axis=-1)
        p_own = p[..., :MOBA_BLOCK]
        p_sel = p[..., MOBA_BLOCK:].reshape(B, H, Q_CHUNK, k_sel, MOBA_BLOCK)
        return (jnp.einsum('bhqk,bhkd->bhqd', p_own, v_own)
                + jnp.einsum('bhqnk,bhqnkd->bhqd', p_sel, v_g))

    outs = lax.map(chunk, jnp.arange(n_chunks))
    out = outs.transpose(1, 2, 0, 3, 4).reshape(B, H, S, Dh)
    return out.astype(q.dtype)


def s5_ssm(u, lam_re, lam_im, log_dt, b_re, b_im, c_re, c_im, d_skip):
    Bt, S, _ = u.shape
    uf = u.astype(jnp.float32).reshape(Bt, S, SSM_GROUPS, SSM_GROUP)
    lam_re = lam_re.astype(jnp.float32)
    lam_im = lam_im.astype(jnp.float32)
    dt = jnp.exp(log_dt.astype(jnp.float32))[:, None]
    mag = jnp.exp(lam_re * dt)
    ab_r = mag * jnp.cos(lam_im * dt)
    ab_i = mag * jnp.sin(lam_im * dt)
    num_r = ab_r - 1.0
    num_i = ab_i
    den = lam_re * lam_re + lam_im * lam_im
    f_r = (num_r * lam_re + num_i * lam_im) / den
    f_i = (num_i * lam_re - num_r * lam_im) / den
    br = b_re.astype(jnp.float32)
    bim = b_im.astype(jnp.float32)
    bb_r = f_r[..., None] * br - f_i[..., None] * bim
    bb_i = f_r[..., None] * bim + f_i[..., None] * br
    xr = jnp.einsum('bsgh,gph->bsgp', uf, bb_r)
    xi = jnp.einsum('bsgh,gph->bsgp', uf, bb_i)
    a_r = jnp.broadcast_to(ab_r, xr.shape)
    a_i = jnp.broadcast_to(ab_i, xr.shape)

    def combine(e1, e2):
        a1r, a1i, b1r, b1i = e1
        a2r, a2i, b2r, b2i = e2
        return (a2r * a1r - a2i * a1i,
                a2r * a1i + a2i * a1r,
                a2r * b1r - a2i * b1i + b2r,
                a2r * b1i + a2i * b1r + b2i)

    _, _, hr, hi = lax.associative_scan(combine, (a_r, a_i, xr, xi), axis=1)
    y = (jnp.einsum('bsgp,ghp->bsgh', hr, c_re.astype(jnp.float32))
         - jnp.einsum('bsgp,ghp->bsgh', hi, c_im.astype(jnp.float32))
         + d_skip.astype(jnp.float32).reshape(SSM_GROUPS, SSM_GROUP) * uf)
    return y.reshape(Bt, S, SSM_WIDTH)


def setup_inputs(seed: int = 0) -> dict:
    key = jax.random.key(seed)
    ks = jax.random.split(key, 32)
    L = DEPTH
    f32 = jnp.float32

    def w(k, shape, fan_in):
        return jax.random.normal(k, shape, f32) * fan_in ** -0.5

    def gain(k, shape):
        return 1.0 + 0.02 * jax.random.normal(k, shape, f32)

    n = jnp.arange(SSM_STATE, dtype=f32)
    lam_re = -0.5 + 0.01 * jax.random.normal(ks[10], (L, SSM_GROUPS, SSM_STATE), f32)
    lam_im = math.pi * n + 0.01 * jax.random.normal(ks[11], (L, SSM_GROUPS, SSM_STATE), f32)
    log_dt = jax.random.uniform(ks[12], (L, SSM_GROUPS), f32, math.log(DT_MIN), math.log(DT_MAX))
    return {
        "x": jax.random.normal(ks[0], (BATCH, SEQ, D_MODEL), f32),
        "ffn1_norm": gain(ks[1], (L, D_MODEL)),
        "ffn1_w_gate": w(ks[2], (L, D_MODEL, D_FF), D_MODEL),
        "ffn1_w_up": w(ks[3], (L, D_MODEL, D_FF), D_MODEL),
        "ffn1_w_down": w(ks[4], (L, D_FF, D_MODEL), D_FF),
        "mix_norm": gain(ks[5], (L, D_MODEL)),
        "w_in": w(ks[6], (L, D_MODEL, IN_WIDTH), D_MODEL),
        "w_attn_up": w(ks[7], (L, ATTN_WIDTH, D_MODEL), ATTN_WIDTH),
        "ssm_lambda_re": lam_re,
        "ssm_lambda_im": lam_im,
        "ssm_log_dt": log_dt,
        "ssm_b_re": w(ks[13], (L, SSM_GROUPS, SSM_STATE, SSM_GROUP), 2 * SSM_GROUP),
        "ssm_b_im": w(ks[14], (L, SSM_GROUPS, SSM_STATE, SSM_GROUP), 2 * SSM_GROUP),
        "ssm_c_re": w(ks[15], (L, SSM_GROUPS, SSM_GROUP, SSM_STATE), 2 * SSM_STATE),
        "ssm_c_im": w(ks[16], (L, SSM_GROUPS, SSM_GROUP, SSM_STATE), 2 * SSM_STATE),
        "ssm_d": jax.random.normal(ks[17], (L, SSM_WIDTH), f32),
        "w_ssm_glu": w(ks[18], (L, SSM_WIDTH, 2 * D_MODEL), SSM_WIDTH),
        "w_out": w(ks[19], (L, D_MODEL, D_MODEL), D_MODEL),
        "ffn2_norm": gain(ks[20], (L, D_MODEL)),
        "ffn2_w_gate": w(ks[21], (L, D_MODEL, D_FF), D_MODEL),
        "ffn2_w_up": w(ks[22], (L, D_MODEL, D_FF), D_MODEL),
        "ffn2_w_down": w(ks[23], (L, D_FF, D_MODEL), D_FF),
        "final_norm": gain(ks[24], (D_MODEL,)),
    }


def reference(x, ffn1_norm, ffn1_w_gate, ffn1_w_up, ffn1_w_down, mix_norm, w_in, w_attn_up,
              ssm_lambda_re, ssm_lambda_im, ssm_log_dt, ssm_b_re, ssm_b_im, ssm_c_re, ssm_c_im,
              ssm_d, w_ssm_glu, w_out, ffn2_norm, ffn2_w_gate, ffn2_w_up, ffn2_w_down,
              final_norm):
    B, S, _ = x.shape
    for l in range(DEPTH):
        h = rms_norm(x, ffn1_norm[l])
        x = x + 0.5 * swiglu(h, ffn1_w_gate[l], ffn1_w_up[l], ffn1_w_down[l])
        h = rms_norm(x, mix_norm[l])
        proj = h @ w_in[l]
        q, k, v, u, g_attn, g_ssm = jnp.split(proj, SPLIT_POINTS, axis=-1)
        q = q.reshape(B, S, N_HEADS, HEAD_DIM).transpose(0, 2, 1, 3)
        k = k.reshape(B, S, N_HEADS, HEAD_DIM).transpose(0, 2, 1, 3)
        v = v.reshape(B, S, N_HEADS, HEAD_DIM).transpose(0, 2, 1, 3)
        attn = moba_attention(q, k, v).transpose(0, 2, 1, 3).reshape(B, S, ATTN_WIDTH)
        attn = attn @ w_attn_up[l]
        y = s5_ssm(u, ssm_lambda_re[l], ssm_lambda_im[l], ssm_log_dt[l], ssm_b_re[l],
                   ssm_b_im[l], ssm_c_re[l], ssm_c_im[l], ssm_d[l]).astype(x.dtype)
        y_val, y_gate = jnp.split(jax.nn.gelu(y) @ w_ssm_glu[l], 2, axis=-1)
        ssm_out = y_val * jax.nn.sigmoid(y_gate)
        merged = jax.nn.sigmoid(g_attn) * attn + jax.nn.sigmoid(g_ssm) * ssm_out
        x = x + merged @ w_out[l]
        h = rms_norm(x, ffn2_norm[l])
        x = x + 0.5 * swiglu(h, ffn2_w_gate[l], ffn2_w_up[l], ffn2_w_down[l])
    return rms_norm(x, final_norm)
```

```cpp
#include <hip/hip_runtime.h>
#include <math.h>
#include <stdint.h>
#include <stdio.h>

#define D_MODEL 1024
#define SEQ 8192
#define BATCH 2
#define MTOK (BATCH * SEQ)
#define NH 8
#define HD 64
#define AW 512
#define MBLK 256
#define NBLK 32
#define SW 512
#define DFF 2816
#define INW 4096
#define CH 2048

__device__ __forceinline__ float wave_sum(float v) {
#pragma unroll
    for (int o = 1; o < 64; o <<= 1) v += __shfl_xor(v, o);
    return v;
}
__device__ __forceinline__ float wave_max(float v) {
#pragma unroll
    for (int o = 1; o < 64; o <<= 1) v = fmaxf(v, __shfl_xor(v, o));
    return v;
}
__device__ __forceinline__ float bcast(float v, int l) { return __int_as_float(__builtin_amdgcn_readlane(__float_as_int(v), l)); }

__global__ __launch_bounds__(256) void rmsnorm_k(const float* x, const float* __restrict__ g, float* out) {
    __shared__ float red[4];
    const size_t row = blockIdx.x;
    const int tid = threadIdx.x;
    const float4 v = *(const float4*)(x + row * D_MODEL + tid * 4);
    float s = v.x * v.x + v.y * v.y + v.z * v.z + v.w * v.w;
    s = wave_sum(s);
    if ((tid & 63) == 0) red[tid >> 6] = s;
    __syncthreads();
    const float tot = (red[0] + red[1]) + (red[2] + red[3]);
    const float rs = 1.0f / sqrtf(tot * (1.0f / D_MODEL) + 1e-6f);
    const float4 gg = *(const float4*)(g + tid * 4);
    float4 o;
    o.x = v.x * rs * gg.x; o.y = v.y * rs * gg.y; o.z = v.z * rs * gg.z; o.w = v.w * rs * gg.w;
    *(float4*)(out + row * D_MODEL + tid * 4) = o;
}

template <int EPI>
__global__ __launch_bounds__(256) void sgemm_k(const float* __restrict__ A, int lda, const float* __restrict__ B, int ldb, float* C, int ldc, int K,
                                               const float* R, int ldr, float alpha) {
    __shared__ float As[16][132];
    __shared__ float Bs[16][132];
    const int tid = threadIdx.x, tx = tid & 15, ty = tid >> 4;
    const int m0 = blockIdx.y * 128, n0 = blockIdx.x * 128;
    float acc[8][8];
#pragma unroll
    for (int i = 0; i < 8; ++i)
#pragma unroll
        for (int j = 0; j < 8; ++j) acc[i][j] = 0.f;
    const int ar = tid >> 2, ak = (tid & 3) * 4;
    const int bk = tid >> 5, bc = (tid & 31) * 4;
    const float* Ap = A + (size_t)(m0 + ar) * lda + ak;
    const float* Bp = B + (size_t)bk * ldb + n0 + bc;
    for (int k0 = 0; k0 < K; k0 += 16) {
        const float4 a0 = *(const float4*)(Ap + k0);
        const float4 a1 = *(const float4*)(Ap + (size_t)64 * lda + k0);
        const float4 b0 = *(const float4*)(Bp + (size_t)k0 * ldb);
        const float4 b1 = *(const float4*)(Bp + (size_t)(k0 + 8) * ldb);
        __syncthreads();
        As[ak + 0][ar] = a0.x; As[ak + 1][ar] = a0.y; As[ak + 2][ar] = a0.z; As[ak + 3][ar] = a0.w;
        As[ak + 0][ar + 64] = a1.x; As[ak + 1][ar + 64] = a1.y; As[ak + 2][ar + 64] = a1.z; As[ak + 3][ar + 64] = a1.w;
        *(float4*)&Bs[bk][bc] = b0;
        *(float4*)&Bs[bk + 8][bc] = b1;
        __syncthreads();
#pragma unroll
        for (int k = 0; k < 16; ++k) {
            const float4 x0 = *(const float4*)&As[k][ty * 8], x1 = *(const float4*)&As[k][ty * 8 + 4];
            const float4 y0 = *(const float4*)&Bs[k][tx * 8], y1 = *(const float4*)&Bs[k][tx * 8 + 4];
            const float a[8] = {x0.x, x0.y, x0.z, x0.w, x1.x, x1.y, x1.z, x1.w};
            const float b[8] = {y0.x, y0.y, y0.z, y0.w, y1.x, y1.y, y1.z, y1.w};
#pragma unroll
            for (int i = 0; i < 8; ++i)
#pragma unroll
                for (int j = 0; j < 8; ++j) acc[i][j] = fmaf(a[i], b[j], acc[i][j]);
        }
    }
#pragma unroll
    for (int i = 0; i < 8; ++i) {
        const size_t row = m0 + ty * 8 + i;
        float* cp = C + row * ldc + n0 + tx * 8;
        float4 o0 = {acc[i][0], acc[i][1], acc[i][2], acc[i][3]}, o1 = {acc[i][4], acc[i][5], acc[i][6], acc[i][7]};
        if (EPI == 1) {
            const float* rp = R + row * ldr + n0 + tx * 8;
            const float4 r0 = *(const float4*)rp, r1 = *(const float4*)(rp + 4);
            o0.x = r0.x + alpha * o0.x; o0.y = r0.y + alpha * o0.y; o0.z = r0.z + alpha * o0.z; o0.w = r0.w + alpha * o0.w;
            o1.x = r1.x + alpha * o1.x; o1.y = r1.y + alpha * o1.y; o1.z = r1.z + alpha * o1.z; o1.w = r1.w + alpha * o1.w;
        }
        *(float4*)cp = o0;
        *(float4*)(cp + 4) = o1;
    }
}

__device__ __forceinline__ float sigmoidf_(float x) { return 1.0f / (1.0f + expf(-x)); }
__device__ __forceinline__ float gelu_tanh(float x) { return 0.5f * x * (1.0f + tanhf(0.7978845608028654f * (x + 0.044715f * x * x * x))); }

__global__ void swiglu_k(float* G, const float* U, size_t n) {
    size_t i = (size_t)blockIdx.x * blockDim.x + threadIdx.x;
    if (i < n) { const float g = G[i]; G[i] = g * sigmoidf_(g) * U[i]; }
}
__global__ void gelu_k(const float* y, float* o, size_t n) {
    size_t i = (size_t)blockIdx.x * blockDim.x + threadIdx.x;
    if (i < n) o[i] = gelu_tanh(y[i]);
}
__global__ void merge_k(const float* ga, const float* gs, const float* aup, const float* glu, float* mg, size_t rows) {
    size_t i = (size_t)blockIdx.x * blockDim.x + threadIdx.x;
    if (i < rows * 1024) {
        const size_t r = i >> 10, c = i & 1023;
        const float val = glu[r * 2048 + c], gt = glu[r * 2048 + 1024 + c];
        mg[i] = sigmoidf_(ga[i]) * aup[i] + sigmoidf_(gs[i]) * (val * sigmoidf_(gt));
    }
}

__global__ __launch_bounds__(64) void kmean_k(const float* __restrict__ k, float* kmean) {
    const int blk = blockIdx.x, h = blockIdx.y, b = blockIdx.z, d = threadIdx.x;
    const float* kp = k + ((size_t)(b * SEQ + blk * MBLK)) * AW + h * HD + d;
    float s = 0.f;
    for (int j = 0; j < MBLK; ++j) s += kp[(size_t)j * AW];
    kmean[((size_t)(b * NH + h) * NBLK + blk) * HD + d] = s * (1.0f / MBLK);
}

__global__ __launch_bounds__(256) void attn_naive_k(const float* __restrict__ q, int row0, const float* __restrict__ k, const float* __restrict__ v,
                                                    const float* __restrict__ kmean, float* out) {
    __shared__ float sc[4][1024];
    const int wave = threadIdx.x >> 6, lane = threadIdx.x & 63;
    const int lrow = blockIdx.x * 4 + wave, h = blockIdx.y;
    const int grow = row0 + lrow, b = grow / SEQ, t = grow % SEQ, blk = t / MBLK, r = t % MBLK;
    const float qv = q[(size_t)lrow * AW + h * HD + lane];
    float gate;
    {
        const int n = lane & 31;
        const float* km = kmean + ((size_t)(b * NH + h) * NBLK + n) * HD;
        float s = 0.f;
#pragma unroll
        for (int d = 0; d < 64; ++d) s = fmaf(bcast(qv, d), km[d], s);
        gate = (lane < blk) ? s : -INFINITY;
    }
    int sel[3];
#pragma unroll
    for (int i = 0; i < 3; ++i) {
        const float m = wave_max(gate);
        if (m == -INFINITY) { sel[i] = -1; }
        else {
            const unsigned long long bal = __ballot(gate == m);
            const int idx = __ffsll((long long)bal) - 1;
            sel[i] = idx;
            if (lane == idx) gate = -INFINITY;
        }
    }
    const float slope = exp2f(-(float)(h + 1));
    float mx = -INFINITY;
    _Pragma("unroll") for (int seg = 0; seg < 4; ++seg) {
        const int nb = (seg == 0) ? blk : sel[seg - 1];
        if (nb < 0) continue;
        for (int jb = 0; jb < 4; ++jb) {
            const int j = jb * 64 + lane, key = nb * MBLK + j;
            const float* kr = k + ((size_t)(b * SEQ + key)) * AW + h * HD;
            float s = 0.f;
#pragma unroll
            for (int d4 = 0; d4 < 16; ++d4) {
                const float4 kk = *(const float4*)(kr + d4 * 4);
                s = fmaf(bcast(qv, 4 * d4 + 0), kk.x, s); s = fmaf(bcast(qv, 4 * d4 + 1), kk.y, s);
                s = fmaf(bcast(qv, 4 * d4 + 2), kk.z, s); s = fmaf(bcast(qv, 4 * d4 + 3), kk.w, s);
            }
            s = s * 0.125f - slope * fabsf((float)(t - key));
            if (seg == 0 && j > r) s = -INFINITY;
            sc[wave][seg * 256 + j] = s;
            mx = fmaxf(mx, s);
        }
    }
    mx = wave_max(mx);
    __syncthreads();
    float l = 0.f, acc = 0.f;
    _Pragma("unroll") for (int seg = 0; seg < 4; ++seg) {
        const int nb = (seg == 0) ? blk : sel[seg - 1];
        if (nb < 0) continue;
        const int jn = (seg == 0) ? (r + 1) : 256;
        const float* vp = v + ((size_t)(b * SEQ + nb * MBLK)) * AW + h * HD + lane;
        for (int j = 0; j < jn; ++j) {
            const float p = expf(sc[wave][seg * 256 + j] - mx);
            l += p;
            acc = fmaf(p, vp[(size_t)j * AW], acc);
        }
    }
    out[(size_t)lrow * AW + h * HD + lane] = acc / l;
}

__global__ void ssm_prep_k(const float* lre, const float* lim, const float* logdt, const float* bre, const float* bim, float* abr, float* abi, float* bbr, float* bbi) {
    const int i = blockIdx.x * blockDim.x + threadIdx.x;
    if (i >= 32 * 64) return;
    const int g = i >> 6;
    const double lr = lre[i], li = lim[i], dt = exp((double)logdt[g]);
    const double mag = exp(lr * dt), ar = mag * cos(li * dt), ai = mag * sin(li * dt);
    const double nr = ar - 1.0, ni = ai, den = lr * lr + li * li;
    const double fr = (nr * lr + ni * li) / den, fi = (ni * lr - nr * li) / den;
    abr[i] = (float)ar; abi[i] = (float)ai;
    for (int h = 0; h < 16; ++h) {
        const double br = bre[i * 16 + h], bi = bim[i * 16 + h];
        bbr[i * 16 + h] = (float)(fr * br - fi * bi);
        bbi[i * 16 + h] = (float)(fr * bi + fi * br);
    }
}
__global__ __launch_bounds__(64) void ssm_scan_k(float* uy, const float* abr, const float* abi, const float* bbr, const float* bbi, const float* cre, const float* cim, const float* dsk) {
    __shared__ float hs_r[16][64], hs_i[16][64], us[16][16], cr[16][64], ci[16][64];
    const int g = blockIdx.x, b = blockIdx.y, p = threadIdx.x;
    const int gp = g * 64 + p;
    const float ar = abr[gp], ai = abi[gp];
    float br[16], bi[16];
#pragma unroll
    for (int h = 0; h < 16; ++h) { br[h] = bbr[gp * 16 + h]; bi[h] = bbi[gp * 16 + h]; }
    for (int c = 0; c < 16; ++c) { cr[c][p] = cre[(g * 16 + c) * 64 + p]; ci[c][p] = cim[(g * 16 + c) * 64 + p]; }
    const int oc0 = (p & 3) * 4, os = p >> 2;
    float dd[4];
#pragma unroll
    for (int j = 0; j < 4; ++j) dd[j] = dsk[g * 16 + oc0 + j];
    float hr = 0.f, hi = 0.f;
    float* base = uy + (size_t)b * SEQ * SW + g * 16;
    for (int t0 = 0; t0 < SEQ; t0 += 16) {
        __syncthreads();
#pragma unroll
        for (int j = 0; j < 4; ++j) { const int idx = p * 4 + j, s = idx >> 4, c = idx & 15; us[s][c] = base[(size_t)(t0 + s) * SW + c]; }
        __syncthreads();
#pragma unroll
        for (int s = 0; s < 16; ++s) {
            float xr = 0.f, xi = 0.f;
#pragma unroll
            for (int h = 0; h < 16; ++h) { const float u = us[s][h]; xr = fmaf(br[h], u, xr); xi = fmaf(bi[h], u, xi); }
            const float nr = ar * hr - ai * hi + xr, ni = ar * hi + ai * hr + xi;
            hr = nr; hi = ni;
            hs_r[s][p] = hr; hs_i[s][p] = hi;
        }
        __syncthreads();
        float y[4] = {0.f, 0.f, 0.f, 0.f};
        for (int pp = 0; pp < 64; ++pp) {
            const float a = hs_r[os][pp], bq = hs_i[os][pp];
#pragma unroll
            for (int j = 0; j < 4; ++j) y[j] += a * cr[oc0 + j][pp] - bq * ci[oc0 + j][pp];
        }
#pragma unroll
        for (int j = 0; j < 4; ++j) base[(size_t)(t0 + os) * SW + oc0 + j] = y[j] + dd[j] * us[os][oc0 + j];
    }
}

static void gemm(hipStream_t st, const float* A, int lda, const float* B, int ldb, float* C, int ldc, int M, int N, int K) {
    sgemm_k<0><<<dim3(N / 128, M / 128), 256, 0, st>>>(A, lda, B, ldb, C, ldc, K, nullptr, 0, 0.f);
}
static void gemm_res(hipStream_t st, const float* A, int lda, const float* B, int ldb, float* C, int ldc, int M, int N, int K, const float* R, int ldr, float alpha) {
    sgemm_k<1><<<dim3(N / 128, M / 128), 256, 0, st>>>(A, lda, B, ldb, C, ldc, K, R, ldr, alpha);
}

extern "C" void kernel_launch(void* const* d_in, const int* in_sizes, int n_in, void* d_out, int out_size, void* d_ws, size_t ws_size, hipStream_t stream) {
    const float* x = (const float*)d_in[0];
    const float* n1 = (const float*)d_in[1];
    const float *wg1 = (const float*)d_in[2], *wu1 = (const float*)d_in[3], *wd1 = (const float*)d_in[4];
    const float* nm = (const float*)d_in[5];
    const float* win = (const float*)d_in[6];
    const float* wau = (const float*)d_in[7];
    const float *lre = (const float*)d_in[8], *lim = (const float*)d_in[9], *ldt = (const float*)d_in[10];
    const float *bre = (const float*)d_in[11], *bim = (const float*)d_in[12], *cre = (const float*)d_in[13], *cim = (const float*)d_in[14], *dsk = (const float*)d_in[15];
    const float* wglu = (const float*)d_in[16];
    const float* wout = (const float*)d_in[17];
    const float* n2 = (const float*)d_in[18];
    const float *wg2 = (const float*)d_in[19], *wu2 = (const float*)d_in[20], *wd2 = (const float*)d_in[21];
    const float* nf = (const float*)d_in[22];
    float* out = (float*)d_out;
    float* ws = (float*)d_ws;
    size_t off = 0;
    auto take = [&](size_t n) { float* p = ws + off; off += (n + 63) & ~(size_t)63; return p; };
    float* kb = take((size_t)MTOK * AW);
    float* vb = take((size_t)MTOK * AW);
    float* ub = take((size_t)MTOK * AW);
    float* kmean = take(BATCH * NH * NBLK * HD);
    float* abr = take(2048); float* abi = take(2048); float* bbr = take(2048 * 16); float* bbi = take(2048 * 16);
    float* hc = take((size_t)CH * 1024);
    float* G = take((size_t)CH * DFF);
    float* U = take((size_t)CH * DFF);
    float* qc = take((size_t)CH * AW);
    float* ac = take((size_t)CH * AW);
    float* aup = take((size_t)CH * 1024);
    float* ga = take((size_t)CH * 1024);
    float* gs = take((size_t)CH * 1024);
    float* glu = take((size_t)CH * 2048);
    float* mg = take((size_t)CH * 1024);
    if (off * 4 > ws_size) { fprintf(stderr, "ws too small: need %zu have %zu\n", off * 4, ws_size); return; }

    const size_t nact = (size_t)CH * DFF;
    for (int r0 = 0; r0 < MTOK; r0 += CH) {
        const float* xc = x + (size_t)r0 * 1024;
        float* x1 = out + (size_t)r0 * 1024;
        rmsnorm_k<<<CH, 256, 0, stream>>>(xc, n1, hc);
        gemm(stream, hc, 1024, wg1, DFF, G, DFF, CH, DFF, 1024);
        gemm(stream, hc, 1024, wu1, DFF, U, DFF, CH, DFF, 1024);
        swiglu_k<<<(unsigned)((nact + 255) / 256), 256, 0, stream>>>(G, U, nact);
        gemm_res(stream, G, DFF, wd1, 1024, x1, 1024, CH, 1024, DFF, xc, 1024, 0.5f);
        rmsnorm_k<<<CH, 256, 0, stream>>>(x1, nm, hc);
        gemm(stream, hc, 1024, win + 512, INW, kb + (size_t)r0 * AW, AW, CH, AW, 1024);
        gemm(stream, hc, 1024, win + 1024, INW, vb + (size_t)r0 * AW, AW, CH, AW, 1024);
        gemm(stream, hc, 1024, win + 1536, INW, ub + (size_t)r0 * AW, AW, CH, AW, 1024);
    }
    kmean_k<<<dim3(NBLK, NH, BATCH), 64, 0, stream>>>(kb, kmean);
    ssm_prep_k<<<8, 256, 0, stream>>>(lre, lim, ldt, bre, bim, abr, abi, bbr, bbi);
    ssm_scan_k<<<dim3(32, BATCH), 64, 0, stream>>>(ub, abr, abi, bbr, bbi, cre, cim, dsk);
    for (int r0 = 0; r0 < MTOK; r0 += CH) {
        float* x1 = out + (size_t)r0 * 1024;
        rmsnorm_k<<<CH, 256, 0, stream>>>(x1, nm, hc);
        gemm(stream, hc, 1024, win, INW, qc, AW, CH, AW, 1024);
        gemm(stream, hc, 1024, win + 2048, INW, ga, 1024, CH, 1024, 1024);
        gemm(stream, hc, 1024, win + 3072, INW, gs, 1024, CH, 1024, 1024);
        attn_naive_k<<<dim3(CH / 4, NH), 256, 0, stream>>>(qc, r0, kb, vb, kmean, ac);
        gemm(stream, ac, AW, wau, 1024, aup, 1024, CH, 1024, AW);
        gelu_k<<<(CH * SW + 255) / 256, 256, 0, stream>>>(ub + (size_t)r0 * SW, qc, (size_t)CH * SW);
        gemm(stream, qc, SW, wglu, 2048, glu, 2048, CH, 2048, SW);
        merge_k<<<(CH * 1024 + 255) / 256, 256, 0, stream>>>(ga, gs, aup, glu, mg, CH);
        gemm_res(stream, mg, 1024, wout, 1024, x1, 1024, CH, 1024, 1024, x1, 1024, 1.0f);
        rmsnorm_k<<<CH, 256, 0, stream>>>(x1, n2, hc);
        gemm(stream, hc, 1024, wg2, DFF, G, DFF, CH, DFF, 1024);
        gemm(stream, hc, 1024, wu2, DFF, U, DFF, CH, DFF, 1024);
        swiglu_k<<<(unsigned)((nact + 255) / 256), 256, 0, stream>>>(G, U, nact);
        gemm_res(stream, G, DFF, wd2, 1024, x1, 1024, CH, 1024, DFF, x1, 1024, 0.5f);
        rmsnorm_k<<<CH, 256, 0, stream>>>(x1, nf, x1);
    }
}
```

```cpp
#include <hip/hip_runtime.h>
#include <cstdio>
#include <cstdint>
#include <cmath>

#define LAS __attribute__((address_space(3)))
#define GAS __attribute__((address_space(1)))
typedef unsigned short bf16_t;
typedef short bf16x8 __attribute__((ext_vector_type(8)));
typedef short v4i16_t __attribute__((ext_vector_type(4)));
typedef float f32x2 __attribute__((ext_vector_type(2)));
typedef float f32x4 __attribute__((ext_vector_type(4)));
typedef float f32x16 __attribute__((ext_vector_type(16)));
typedef unsigned u32x2 __attribute__((ext_vector_type(2)));
typedef unsigned u32x4 __attribute__((ext_vector_type(4)));
typedef __bf16 bf16x2_t __attribute__((ext_vector_type(2)));

constexpr int BATCH = 2, SEQ = 8192, DM = 1024, M = BATCH * SEQ;
constexpr int NH = 8, HD = 64, AW = 512, MBLK = 256, NBLK = 32;
constexpr int SW = 512, DFF = 2816, INW = 4096;
constexpr int SCH = 32, NCHUNK = M / SCH  , UK = 640  ;
constexpr float EPS = 1e-6f;
constexpr float LOG2E = 1.4426950408889634f;
constexpr float QSCALE = 0.125f * LOG2E;

__device__ __forceinline__ unsigned cvtpk(float lo, float hi) { f32x2 v = {lo, hi}; bf16x2_t b = __builtin_convertvector(v, bf16x2_t); return __builtin_bit_cast(unsigned, b); }
__device__ __forceinline__ float bf_lo(unsigned w) { return __uint_as_float(w << 16); }
__device__ __forceinline__ float bf_hi(unsigned w) { return __uint_as_float(w & 0xffff0000u); }
__device__ __forceinline__ float fast_sigmoid(float x) { return __builtin_amdgcn_rcpf(1.0f + __builtin_amdgcn_exp2f(-LOG2E * x)); }
__device__ __forceinline__ float gelu_tanh_f(float x) {
    const float z = 0.7978845608028654f * (x + 0.044715f * x * x * x);
    return x * __builtin_amdgcn_rcpf(1.0f + __builtin_amdgcn_exp2f(-2.0f * LOG2E * z));
}

namespace pg8 {
constexpr int BM = 256, BK = 64, HALF = 128, HTB = HALF * BK * 2, STAGE_BYTES = 8 * HTB, NXCD = 8, WGM = 8;
__host__ __device__ __forceinline__ int lds_byte(int r, int c) { const int st = (r >> 4) * 2 + (c >> 5), rr = r & 15, cc = c & 31, ob = rr * 64 + cc * 2; return st * 1024 + (ob ^ (((ob >> 9) & 1) << 5)); }
__host__ __device__ __forceinline__ void stage_rc(int b, int& R, int& C) { const int st = b / 1024, sb = b % 1024, swz = sb ^ (((sb >> 9) & 1) << 5); R = (st >> 1) * 16 + swz / 64; C = (st & 1) * 32 + (swz % 64) / 2; }
__host__ __device__ __forceinline__ int perm32(int rho) { const int n = rho >> 4, i = rho & 15; return 8 * (i >> 2) + 4 * n + (i & 3); }

struct Unit { int pm, pn, pb; };
struct Gemm { const bf16_t* A; const bf16_t* Bt; int lda, ldb, K; size_t bsA, bsB; };

struct Order {
    int nM, nN, nB, nwg, G, c; bool grouped;
    __device__ void init(int nM_, int nN_, int nB_, int G_, int c_) { nM = nM_; nN = nN_; nB = nB_; nwg = nM * nN * nB; G = G_; c = c_; grouped = nB_ > 1; }
    __device__ bool next(int i, Unit& u) const {
        const long L = (long)i * G + c; if (c < 0 || L >= nwg) return false;
        if (grouped) { const int l = (int)L, per = nM * nN; u.pb = l / per; const int r = l % per; u.pn = r / nM; u.pm = r % nM; return true; }
        int wgid = (int)L; { const int q = nwg / NXCD, r = nwg % NXCD, xcd = wgid % NXCD, off = wgid / NXCD; wgid = (xcd < r ? xcd * (q + 1) : r * (q + 1) + (xcd - r) * q) + off; }
        const int nig = WGM * nN, gid = wgid / nig, fm = gid * WGM, gsz = (nM - fm) < WGM ? (nM - fm) : WGM;
        u.pm = fm + ((wgid % nig) % gsz); u.pn = (wgid % nig) / gsz; u.pb = 0; return true;
    }
};

enum EpMode { EP_SWIGLU = 0, EP_RESID, EP_PROJ, EP_GATES, EP_SLOC, EP_Y, EP_BF16, EP_MERGE };
struct Epi {
    int mode; bool perm;
    const float* ss;
    bf16_t* O;
    bf16_t* O2;
    const float* R; float* out; bf16_t* xb; float* ss_out; float alpha;
    bf16_t *Q, *Kimg, *Vimg, *uext; float* kmp;
    float* sloc;
    const float* dsk;
    const bf16_t *aup, *sga, *sgs;
};
__device__ __forceinline__ float row_rs(const float* ss, int row, int fq) {
    const f32x4 v = *(const f32x4*)(ss + (size_t)row * 16 + fq * 4);
    float s = (v[0] + v[1]) + (v[2] + v[3]); s += __shfl_xor(s, 16); s += __shfl_xor(s, 32);
    return __builtin_amdgcn_rsqf(s * (1.0f / DM) + EPS);
}
__device__ __forceinline__ u32x4 pack8(const f32x4 a, const f32x4 b) { u32x4 w; w.x = cvtpk(a[0], a[1]); w.y = cvtpk(a[2], a[3]); w.z = cvtpk(b[0], b[1]); w.w = cvtpk(b[2], b[3]); return w; }

__device__ __forceinline__ void epilogue(const Epi& E, const f32x4 (&acc)[2][2][4][2], const Unit& u, int wr, int wc, int fr, int fq) {
    asm volatile("" : "+v"(fr), "+v"(fq));
    const int rowb = u.pm * BM + wr * 64 + fr;
    if (E.mode == EP_SWIGLU) {
        const int col = u.pn * 128 + wc * 32 + 8 * fq;
#pragma unroll
        for (int ai = 0; ai < 2; ++ai)
#pragma unroll
            for (int m = 0; m < 4; ++m) { const int row = rowb + ai * HALF + m * 16; const float rs = row_rs(E.ss, row, fq);
                f32x4 o[2];
#pragma unroll
                for (int n = 0; n < 2; ++n) { const f32x4 g = acc[ai][0][m][n] * rs, up = acc[ai][1][m][n] * rs;
#pragma unroll
                    for (int j = 0; j < 4; ++j) o[n][j] = g[j] * fast_sigmoid(g[j]) * up[j]; }
                *(u32x4*)(E.O + (size_t)row * DFF + col) = pack8(o[0], o[1]); }
    } else if (E.mode == EP_RESID) {
#pragma unroll
        for (int ai = 0; ai < 2; ++ai)
#pragma unroll
            for (int m = 0; m < 4; ++m) { const int row = rowb + ai * HALF + m * 16; float sq = 0.f;
#pragma unroll
                for (int bj = 0; bj < 2; ++bj)
#pragma unroll
                    for (int n = 0; n < 2; ++n) { const size_t off = (size_t)row * DM + u.pn * BM + bj * HALF + wc * 32 + n * 16 + 4 * fq;
                        const f32x4 r = *(const f32x4*)(E.R + off); const f32x4 v = r + acc[ai][bj][m][n] * E.alpha;
                        *(f32x4*)(E.out + off) = v;
                        if (E.xb) { u32x2 w; w.x = cvtpk(v[0], v[1]); w.y = cvtpk(v[2], v[3]); *(u32x2*)(E.xb + off) = w; }
                        sq += (v[0] * v[0] + v[1] * v[1]) + (v[2] * v[2] + v[3] * v[3]); }
                sq += __shfl_xor(sq, 16); sq += __shfl_xor(sq, 32);
                if (fq == 0) E.ss_out[(size_t)row * 16 + u.pn * 4 + wc] = sq; }
    } else if (E.mode == EP_PROJ) {
        const int c0t = u.pn * BM + wc * 32 + 8 * fq;
        const int b = u.pm >> 5, blk = u.pm & 31;
        float ksum[2][8];
#pragma unroll
        for (int bj = 0; bj < 2; ++bj)
#pragma unroll
            for (int j = 0; j < 8; ++j) ksum[bj][j] = 0.f;
#pragma unroll
        for (int ai = 0; ai < 2; ++ai)
#pragma unroll
            for (int m = 0; m < 4; ++m) { const int row = rowb + ai * HALF + m * 16; const float rs = row_rs(E.ss, row, fq);
                const int key = row & 255, t = row & (SEQ - 1);
#pragma unroll
                for (int bj = 0; bj < 2; ++bj) { const int c0 = c0t + bj * HALF; const f32x4 v0 = acc[ai][bj][m][0] * rs, v1 = acc[ai][bj][m][1] * rs; const u32x4 w = pack8(v0, v1);
                    if (u.pn < 2) { *(u32x4*)(E.Q + (size_t)row * AW + c0) = w; }
                    else if (u.pn < 4) { const int ck = c0 - 512, h = ck >> 6, d0 = ck & 63;
                        *(u32x4*)(E.Kimg + ((size_t)((b * NH + h) * NBLK + blk)) * (MBLK * HD) + (d0 >> 3) * 2048 + key * 8) = w;
#pragma unroll
                        for (int j = 0; j < 4; ++j) { ksum[bj][j] += v0[j]; ksum[bj][4 + j] += v1[j]; } }
                    else if (u.pn < 6) { const int cv = c0 - 1024, h = cv >> 6, d0 = cv & 63;
                        *(u32x4*)(E.Vimg + ((size_t)((b * NH + h) * NBLK + blk)) * (MBLK * HD) + (d0 >> 5) * 8192 + key * 32 + (d0 & 31)) = w; }
                    else { const int cu = c0 - 1536, g = cu >> 4, hh = cu & 15;
                        *(u32x4*)(E.uext + ((size_t)(g * NCHUNK + (row >> 5))) * UK + (row & 31) * 16 + hh) = w; (void)t; } } }
        if (u.pn >= 2 && u.pn < 4) {
#pragma unroll
            for (int bj = 0; bj < 2; ++bj) { const int ck = c0t + bj * HALF - 512, h = ck >> 6, d0 = ck & 63;
#pragma unroll
                for (int j = 0; j < 8; ++j) { float s = ksum[bj][j]; s += __shfl_xor(s, 1); s += __shfl_xor(s, 2); s += __shfl_xor(s, 4); s += __shfl_xor(s, 8); ksum[bj][j] = s; }
                if (fr == 0) { float* kp = E.kmp + ((size_t)(((b * NH + h) * NBLK + blk) * 2 + wr)) * HD + d0;
                    *(f32x4*)kp = (f32x4){ksum[bj][0], ksum[bj][1], ksum[bj][2], ksum[bj][3]}; *(f32x4*)(kp + 4) = (f32x4){ksum[bj][4], ksum[bj][5], ksum[bj][6], ksum[bj][7]}; } }
        }
    } else if (E.mode == EP_GATES) {
        bf16_t* base = (u.pn < 4) ? E.O : E.O2; const int col = (u.pn & 3) * BM + wc * 32 + 8 * fq;
#pragma unroll
        for (int ai = 0; ai < 2; ++ai)
#pragma unroll
            for (int m = 0; m < 4; ++m) { const int row = rowb + ai * HALF + m * 16; const float rs = row_rs(E.ss, row, fq);
#pragma unroll
                for (int bj = 0; bj < 2; ++bj) { f32x4 o[2];
#pragma unroll
                    for (int n = 0; n < 2; ++n)
#pragma unroll
                        for (int j = 0; j < 4; ++j) o[n][j] = fast_sigmoid(acc[ai][bj][m][n][j] * rs);
                    *(u32x4*)(base + (size_t)row * DM + col + bj * HALF) = pack8(o[0], o[1]); } }
    } else if (E.mode == EP_SLOC) {
#pragma unroll
        for (int ai = 0; ai < 2; ++ai)
#pragma unroll
            for (int m = 0; m < 4; ++m) { const int row = rowb + ai * HALF + m * 16;
#pragma unroll
                for (int n = 0; n < 2; ++n) *(f32x4*)(E.sloc + ((size_t)(u.pb * NCHUNK + row)) * 128 + wc * 32 + n * 16 + 4 * fq) = acc[ai][0][m][n]; }
    } else if (E.mode == EP_Y) {
        const int g = u.pb;
#pragma unroll
        for (int ai = 0; ai < 2; ++ai)
#pragma unroll
            for (int m = 0; m < 4; ++m) { const int chunk = rowb + ai * HALF + m * 16;
#pragma unroll
                for (int bj = 0; bj < 2; ++bj) { const int n0 = u.pn * BM + bj * HALF + wc * 32 + 8 * fq, j = n0 >> 4, c0 = n0 & 15;
                    const u32x4 uw = *(const u32x4*)(E.uext + ((size_t)(g * NCHUNK + chunk)) * UK + j * 16 + c0);
                    const f32x4 d0 = *(const f32x4*)(E.dsk + g * 16 + c0), d1 = *(const f32x4*)(E.dsk + g * 16 + c0 + 4);
                    f32x4 y0 = acc[ai][bj][m][0], y1 = acc[ai][bj][m][1];
                    y0[0] += d0[0] * bf_lo(uw.x); y0[1] += d0[1] * bf_hi(uw.x); y0[2] += d0[2] * bf_lo(uw.y); y0[3] += d0[3] * bf_hi(uw.y);
                    y1[0] += d1[0] * bf_lo(uw.z); y1[1] += d1[1] * bf_hi(uw.z); y1[2] += d1[2] * bf_lo(uw.w); y1[3] += d1[3] * bf_hi(uw.w);
#pragma unroll
                    for (int q = 0; q < 4; ++q) { y0[q] = gelu_tanh_f(y0[q]); y1[q] = gelu_tanh_f(y1[q]); }
                    *(u32x4*)(E.O + ((size_t)(chunk * SCH + j)) * SW + g * 16 + c0) = pack8(y0, y1); } }
    } else if (E.mode == EP_BF16) {
#pragma unroll
        for (int ai = 0; ai < 2; ++ai)
#pragma unroll
            for (int m = 0; m < 4; ++m) { const int row = rowb + ai * HALF + m * 16;
#pragma unroll
                for (int bj = 0; bj < 2; ++bj) *(u32x4*)(E.O + (size_t)row * DM + u.pn * BM + bj * HALF + wc * 32 + 8 * fq) = pack8(acc[ai][bj][m][0], acc[ai][bj][m][1]); }
    } else {
        const int col = u.pn * 128 + wc * 32 + 8 * fq;
#pragma unroll
        for (int ai = 0; ai < 2; ++ai)
#pragma unroll
            for (int m = 0; m < 4; ++m) { const int row = rowb + ai * HALF + m * 16; const size_t off = (size_t)row * DM + col;
                const u32x4 wa = *(const u32x4*)(E.aup + off), wga = *(const u32x4*)(E.sga + off), wgs = *(const u32x4*)(E.sgs + off);
                const f32x4 v0 = acc[ai][0][m][0], v1 = acc[ai][0][m][1], t0 = acc[ai][1][m][0], t1 = acc[ai][1][m][1];
                f32x4 o0, o1;
                o0[0] = bf_lo(wga.x) * bf_lo(wa.x) + bf_lo(wgs.x) * (v0[0] * fast_sigmoid(t0[0])); o0[1] = bf_hi(wga.x) * bf_hi(wa.x) + bf_hi(wgs.x) * (v0[1] * fast_sigmoid(t0[1]));
                o0[2] = bf_lo(wga.y) * bf_lo(wa.y) + bf_lo(wgs.y) * (v0[2] * fast_sigmoid(t0[2])); o0[3] = bf_hi(wga.y) * bf_hi(wa.y) + bf_hi(wgs.y) * (v0[3] * fast_sigmoid(t0[3]));
                o1[0] = bf_lo(wga.z) * bf_lo(wa.z) + bf_lo(wgs.z) * (v1[0] * fast_sigmoid(t1[0])); o1[1] = bf_hi(wga.z) * bf_hi(wa.z) + bf_hi(wgs.z) * (v1[1] * fast_sigmoid(t1[1]));
                o1[2] = bf_lo(wga.w) * bf_lo(wa.w) + bf_lo(wgs.w) * (v1[2] * fast_sigmoid(t1[2])); o1[3] = bf_hi(wga.w) * bf_hi(wa.w) + bf_hi(wgs.w) * (v1[3] * fast_sigmoid(t1[3]));
                *(u32x4*)(E.O + off) = pack8(o0, o1); }
    }
}

template <bool ALIGN_EPI, bool SP2>
__device__ __forceinline__ void gemm_phase(LAS unsigned char* lds, const Gemm g, const Order& S, const Epi& E) {
    int tid = threadIdx.x; asm volatile("" : "+v"(tid));
    const int wid = __builtin_amdgcn_readfirstlane(tid >> 6), lane = tid & 63, wr = wid >> 2, wc = wid & 3, fr = lane & 15, fq = lane >> 4;
    const int K = g.K, nt = K / BK;
    unsigned voffA[2], voffB[2];
#pragma unroll
    for (int i = 0; i < 2; ++i) { int R, C; stage_rc(tid * 16 + i * 8192, R, C); const int Rb = E.perm ? ((R & ~31) + perm32(R & 31)) : R;
        voffA[i] = (unsigned)(R * g.lda + C) * 2u; voffB[i] = (unsigned)(Rb * g.ldb + C) * 2u; }
    const size_t kstep = (size_t)(BK * 2);
    const size_t hstepA = (size_t)HALF * g.lda * 2, hstepB = (size_t)HALF * g.ldb * 2;
    const size_t tstepA = 2 * hstepA, tstepB = 2 * hstepB;
    const unsigned ldsw = (unsigned)wid * 1024u;
    const int aoff = lds_byte(wr * 64 + fr, fq * 8), boff = lds_byte(wc * 32 + fr, fq * 8);
#define PG8_SA(b, h) (((b) * 2 + (h)) * HTB)
#define PG8_SB(b, h) ((4 + (b) * 2 + (h)) * HTB)
#define PG8_STAGE(bufoff, gbase, voff) do { _Pragma("unroll") for (int _i = 0; _i < 2; ++_i) \
        __builtin_amdgcn_global_load_lds((const unsigned*)((const char*)(gbase) + (voff)[_i]), (LAS unsigned*)(lds + (bufoff) + ldsw + _i * 8192), 16, 0, 0); } while (0)
#define PG8_LDA(dst, b, h) do { _Pragma("unroll") for (int m = 0; m < 4; ++m) _Pragma("unroll") for (int k = 0; k < 2; ++k) dst[m][k] = *(const LAS bf16x8*)(lds + PG8_SA(b, h) + aoff + m * 2048 + k * 1024); } while (0)
#define PG8_LDB(dst, b, h) do { _Pragma("unroll") for (int n = 0; n < 2; ++n) _Pragma("unroll") for (int k = 0; k < 2; ++k) dst[n][k] = *(const LAS bf16x8*)(lds + PG8_SB(b, h) + boff + n * 2048 + k * 1024); } while (0)
#define PG8_MMA(ai, bj, At, Bt) do { __builtin_amdgcn_s_setprio(1); _Pragma("unroll") for (int m = 0; m < 4; ++m) _Pragma("unroll") for (int n = 0; n < 2; ++n) _Pragma("unroll") for (int k = 0; k < 2; ++k) \
        acc[ai][bj][m][n] = __builtin_amdgcn_mfma_f32_16x16x32_bf16(Bt[n][k], At[m][k], acc[ai][bj][m][n], 0, 0, 0); __builtin_amdgcn_s_setprio(0); } while (0)
#define PG8_WAIT_V(n) asm volatile("s_waitcnt vmcnt(" #n ")" ::: "memory")
#define PG8_WAIT_L(n) asm volatile("s_waitcnt lgkmcnt(" #n ")" ::: "memory")
#define PG8_BAR __builtin_amdgcn_s_barrier()
#define PG8_SCHED __builtin_amdgcn_sched_barrier(0)
    Unit cur, nxt; int ui = 0;
    if (!S.next(0, cur)) return;
    f32x4 acc[2][2][4][2];
#pragma unroll
    for (int a = 0; a < 2; ++a)
#pragma unroll
        for (int b = 0; b < 2; ++b)
#pragma unroll
            for (int m = 0; m < 4; ++m)
#pragma unroll
                for (int n = 0; n < 2; ++n) acc[a][b][m][n] = (f32x4){0.f, 0.f, 0.f, 0.f};
    bf16x8 At[4][2], B0[2][2], B1[2][2];
    const char* cA = (const char*)g.A + (size_t)cur.pb * g.bsA + (size_t)cur.pm * tstepA; const char* cB = (const char*)g.Bt + (size_t)cur.pb * g.bsB + (size_t)cur.pn * tstepB;
    if constexpr (SP2) {
        PG8_STAGE(PG8_SB(0, 0), cB, voffB); PG8_STAGE(PG8_SB(0, 1), cB + hstepB, voffB); PG8_STAGE(PG8_SA(0, 0), cA, voffA); PG8_STAGE(PG8_SA(0, 1), cA + hstepA, voffA);
        if (wr == 1) PG8_BAR;
        PG8_WAIT_V(2); PG8_BAR;
        PG8_STAGE(PG8_SB(1, 0), cB + kstep, voffB); PG8_STAGE(PG8_SA(1, 0), cA + kstep, voffA); PG8_STAGE(PG8_SB(1, 1), cB + hstepB + kstep, voffB);
        PG8_WAIT_V(6); PG8_BAR;
    } else {
        PG8_STAGE(PG8_SB(0, 0), cB, voffB); PG8_STAGE(PG8_SA(0, 0), cA, voffA); PG8_STAGE(PG8_SB(0, 1), cB + hstepB, voffB); PG8_STAGE(PG8_SA(0, 1), cA + hstepA, voffA);
        if (wr == 1) PG8_BAR;
        PG8_WAIT_V(4); PG8_BAR;
        PG8_STAGE(PG8_SB(1, 0), cB + kstep, voffB); PG8_STAGE(PG8_SA(1, 0), cA + kstep, voffA); PG8_STAGE(PG8_SB(1, 1), cB + hstepB + kstep, voffB);
        PG8_WAIT_V(6); PG8_BAR;
    }
    for (;;) {
        const bool has_next = S.next(ui + 1, nxt);
        const char* nA = has_next ? (const char*)g.A + (size_t)nxt.pb * g.bsA + (size_t)nxt.pm * tstepA : cA; const char* nB = has_next ? (const char*)g.Bt + (size_t)nxt.pb * g.bsB + (size_t)nxt.pn * tstepB : cB;
        for (int t = 0; t < nt; t += 2) {
            const bool last = (t == nt - 2);
            const char* a1 = cA + (size_t)(t + 1) * kstep;
            const char* a2 = last ? nA : cA + (size_t)(t + 2) * kstep; const char* b2 = last ? nB : cB + (size_t)(t + 2) * kstep;
            const char* a3 = a2 + kstep; const char* b3 = b2 + kstep;
            if constexpr (SP2) {
            PG8_LDB(B0, 0, 0); PG8_LDB(B1, 0, 1); PG8_SCHED; PG8_LDA(At, 0, 0); PG8_STAGE(PG8_SA(1, 1), a1 + hstepA, voffA);
            PG8_WAIT_V(8); PG8_WAIT_L(0); PG8_BAR; PG8_MMA(0, 0, At, B0); PG8_MMA(0, 1, At, B1); PG8_BAR; PG8_SCHED;
            PG8_LDA(At, 0, 1); PG8_STAGE(PG8_SB(0, 0), b2, voffB); PG8_STAGE(PG8_SB(0, 1), b2 + hstepB, voffB); PG8_STAGE(PG8_SA(0, 0), a2, voffA);
            PG8_WAIT_V(8); PG8_WAIT_L(0); PG8_BAR; PG8_MMA(1, 0, At, B0); PG8_MMA(1, 1, At, B1); PG8_BAR; PG8_SCHED;
            PG8_LDB(B0, 1, 0); PG8_LDB(B1, 1, 1); PG8_SCHED; PG8_LDA(At, 1, 0); PG8_STAGE(PG8_SA(0, 1), a2 + hstepA, voffA);
            PG8_WAIT_V(8); PG8_WAIT_L(0); PG8_BAR; PG8_MMA(0, 0, At, B0); PG8_MMA(0, 1, At, B1); PG8_BAR; PG8_SCHED;
            PG8_LDA(At, 1, 1); PG8_STAGE(PG8_SB(1, 0), b3, voffB); PG8_STAGE(PG8_SB(1, 1), b3 + hstepB, voffB); PG8_STAGE(PG8_SA(1, 0), a3, voffA);
            PG8_WAIT_V(8); PG8_WAIT_L(0); PG8_BAR; PG8_MMA(1, 0, At, B0); PG8_MMA(1, 1, At, B1); PG8_BAR; PG8_SCHED;
            } else {
            PG8_LDB(B0, 0, 0); PG8_SCHED; PG8_LDA(At, 0, 0); PG8_STAGE(PG8_SA(1, 1), a1 + hstepA, voffA);
            PG8_WAIT_L(8); PG8_BAR; PG8_WAIT_L(0); PG8_MMA(0, 0, At, B0); PG8_BAR; PG8_SCHED;
            PG8_LDB(B1, 0, 1); PG8_STAGE(PG8_SB(0, 0), b2, voffB);
            PG8_BAR; PG8_WAIT_L(0); PG8_MMA(0, 1, At, B1); PG8_BAR;
            PG8_LDA(At, 0, 1); PG8_STAGE(PG8_SA(0, 0), a2, voffA);
            PG8_BAR; PG8_WAIT_L(0); PG8_MMA(1, 0, At, B0); PG8_BAR; PG8_SCHED;
            PG8_STAGE(PG8_SB(0, 1), b2 + hstepB, voffB);
            PG8_WAIT_V(6); PG8_BAR; PG8_MMA(1, 1, At, B1); PG8_BAR;
            PG8_LDB(B0, 1, 0); PG8_SCHED; PG8_LDA(At, 1, 0); PG8_STAGE(PG8_SA(0, 1), a2 + hstepA, voffA);
            PG8_WAIT_L(8); PG8_BAR; PG8_WAIT_L(0); PG8_MMA(0, 0, At, B0); PG8_BAR; PG8_SCHED;
            PG8_LDB(B1, 1, 1); PG8_STAGE(PG8_SB(1, 0), b3, voffB);
            PG8_BAR; PG8_WAIT_L(0); PG8_MMA(0, 1, At, B1); PG8_BAR;
            PG8_LDA(At, 1, 1); PG8_STAGE(PG8_SA(1, 0), a3, voffA);
            PG8_BAR; PG8_WAIT_L(0); PG8_MMA(1, 0, At, B0); PG8_BAR; PG8_SCHED;
            PG8_STAGE(PG8_SB(1, 1), b3 + hstepB, voffB);
            PG8_WAIT_V(6); PG8_BAR; PG8_MMA(1, 1, At, B1); PG8_BAR;
            }
        }
        if constexpr (ALIGN_EPI) { if (wr == 0) PG8_BAR; }
        epilogue(E, acc, cur, wr, wc, fr, fq);
        if (!has_next) break;
#pragma unroll
        for (int a = 0; a < 2; ++a)
#pragma unroll
            for (int b = 0; b < 2; ++b)
#pragma unroll
                for (int m = 0; m < 4; ++m)
#pragma unroll
                    for (int n = 0; n < 2; ++n) acc[a][b][m][n] = (f32x4){0.f, 0.f, 0.f, 0.f};
        cur = nxt; cA = nA; cB = nB; ++ui;
        if constexpr (ALIGN_EPI) { if (wr == 1) PG8_BAR; }
    }
    PG8_WAIT_V(0);
    if constexpr (!ALIGN_EPI) { if (wr == 0) PG8_BAR; }
    PG8_BAR;
#undef PG8_SA
#undef PG8_SB
#undef PG8_STAGE
#undef PG8_LDA
#undef PG8_LDB
#undef PG8_MMA
#undef PG8_WAIT_V
#undef PG8_WAIT_L
#undef PG8_BAR
#undef PG8_SCHED
}
}
constexpr size_t MiB = 1u << 20;
constexpr size_t WS_CTL = 0, CTL_ZERO_BYTES = 1 * MiB;
constexpr size_t WS_SS = 1 * MiB;
constexpr size_t WS_KMP = 2 * MiB;
constexpr size_t WS_SEL = 2 * MiB + 512 * 1024;
constexpr size_t WS_COEF = 3 * MiB;
constexpr size_t WS_WGU1 = 4 * MiB, WS_WD1 = 15 * MiB, WS_WIN = WS_WD1 + 5 * MiB + 512 * 1024, WS_WAU = WS_WIN + 8 * MiB, WS_WGLU = WS_WAU + 1 * MiB, WS_WOUT = WS_WGLU + 2 * MiB,
                 WS_WGU2 = WS_WOUT + 2 * MiB, WS_WD2 = WS_WGU2 + 11 * MiB;
static_assert(WS_WD2 + 5 * MiB + 512 * 1024 == 50 * MiB, "weights end at 50 MiB");
constexpr size_t WS_TV = 50 * MiB;
constexpr size_t WS_WLOC = 70 * MiB;
constexpr size_t WS_R1 = 78 * MiB;
constexpr size_t WS_ACT = 110 * MiB;
constexpr size_t WS_Q = 110 * MiB, WS_K = 126 * MiB, WS_V = 142 * MiB, WS_UEXT = 158 * MiB, WS_OPART = 178 * MiB, WS_LPART = 226 * MiB, WS_SLOC = 228 * MiB, WS_GY = 236 * MiB;
constexpr size_t WS_AUP = 126 * MiB, WS_SGA = 158 * MiB, WS_SGS = 190 * MiB, WS_X2B = 198 * MiB, WS_END = 256 * MiB;
constexpr int CW_TMO = 0, CW_CODE = 1, CW_BAR = 4096;

constexpr int RING_BYTES = 131072, LDSCTL_OFF = RING_BYTES, MISC_OFF = LDSCTL_OFF + 320, LDS_BYTES = 147456;
constexpr int NWAVES = 8, NTHR = 512;

#define RLX_AGENT __ATOMIC_RELAXED, __HIP_MEMORY_SCOPE_AGENT
#define LDS_WAIT() asm volatile("s_waitcnt lgkmcnt(0)" ::: "memory")
#define VM_WAIT() asm volatile("s_waitcnt vmcnt(0)" ::: "memory")

#define XB_TMO      128
#define XB_XCNT(j)  (256  + 64 * (j))
#define XB_XSUB(j)  (1280 + 64 * (j))
#define XB_XGEN(j)  (2304 + 64 * (j))
#define XB_TOP      3328
#define XB_TOPGEN   3392
#define XCD_BAR_WORDS 3456
#define XB_SPIN_CAP (1u << 18)
__device__ __forceinline__ unsigned xb_ld(unsigned* p)              { return __hip_atomic_load(p, __ATOMIC_RELAXED, __HIP_MEMORY_SCOPE_AGENT); }
__device__ __forceinline__ unsigned xb_add(unsigned* p, unsigned v) { return __hip_atomic_fetch_add(p, v, __ATOMIC_RELAXED, __HIP_MEMORY_SCOPE_AGENT); }
__device__ __forceinline__ unsigned xb_xcc_id() { return (unsigned)__builtin_amdgcn_s_getreg((3 << 11) | 20) & 0xFu; }
#define XB_SPIN(cond, bar) do { unsigned _sp = 0; while (cond) { __builtin_amdgcn_s_sleep(1); \
    if ((++_sp & 255u) == 0u) { if (xb_ld(&(bar)[XB_TMO])) break; if (_sp > XB_SPIN_CAP) { atomicAdd(&(bar)[XB_TMO], 1u); break; } } } } while (0)
struct XcdBarrier { unsigned* bar; unsigned x; volatile LAS unsigned* st; };
__device__ __forceinline__ XcdBarrier xcd_barrier_post(unsigned* bar, volatile LAS unsigned* st) {
    XcdBarrier b; b.bar = bar; b.x = xb_xcc_id(); b.st = st;
    if (threadIdx.x == 0) (void)xb_add(&bar[XB_XCNT(b.x)], 1u);
    return b;
}
__device__ __forceinline__ void xcd_barrier_complete(unsigned* bar, unsigned x, unsigned& nloc, unsigned& nx) {
    const unsigned G = gridDim.x * gridDim.y * gridDim.z;
    unsigned sum, cnt, mine, sp = 0u;
    for (;;) {
        sum = 0u; cnt = 0u; mine = 0u;
#pragma unroll
        for (unsigned j = 0; j < 16; ++j) { const unsigned c = xb_ld(&bar[XB_XCNT(j)]); sum += c; cnt += (c > 0u) ? 1u : 0u; mine = (j == x) ? c : mine; }
        if (sum == G) break;
        __builtin_amdgcn_s_sleep(1);
        if ((++sp & 255u) == 0u) { if (xb_ld(&bar[XB_TMO])) break; if (sp > XB_SPIN_CAP) { atomicAdd(&bar[XB_TMO], 1u); break; } }
    }
    nloc = mine > 0u ? mine : 1u; nx = cnt > 0u ? cnt : 1u;
}
__device__ __forceinline__ void xcd_barrier(const XcdBarrier& b) {
    asm volatile("s_waitcnt vmcnt(0)" ::: "memory");
    __syncthreads();
    if (threadIdx.x == 0) {
        unsigned* bar = b.bar;
        __builtin_amdgcn_s_waitcnt(0);
        unsigned nloc = b.st[0], nx = b.st[1];
        if (nloc == 0u) { xcd_barrier_complete(bar, b.x, nloc, nx); b.st[0] = nloc; b.st[1] = nx; }
        const unsigned old = xb_add(&bar[XB_XSUB(b.x)], 1u);
        const unsigned gen = old / nloc;
        if (old + 1u == (gen + 1u) * nloc) {
            __builtin_amdgcn_fence(__ATOMIC_RELEASE, "agent");
            asm volatile("s_waitcnt vmcnt(0)" ::: "memory");
            const unsigned og = xb_add(&bar[XB_TOP], 1u);
            const unsigned tg = og / nx;
            if (og + 1u == (tg + 1u) * nx) xb_add(&bar[XB_TOPGEN], 1u);
            else XB_SPIN(xb_ld(&bar[XB_TOPGEN]) == tg, bar);
            __builtin_amdgcn_fence(__ATOMIC_ACQUIRE, "agent");
            xb_add(&bar[XB_XGEN(b.x)], 1u);
            asm volatile("s_waitcnt vmcnt(0)" ::: "memory");
        } else {
            XB_SPIN(xb_ld(&bar[XB_XGEN(b.x)]) == gen, bar);
            __builtin_amdgcn_fence(__ATOMIC_ACQUIRE, "agent");
            asm volatile("s_waitcnt vmcnt(0)" ::: "memory");
        }
    }
    __syncthreads();
}

struct Frame {
    LAS unsigned char* lds;
    int vcu, G;
    unsigned char* ws;
    const float* in[23]; float* out;
};
__device__ __forceinline__ int fresh_tid() { int t = threadIdx.x; asm volatile("" : "+v"(t)); return t; }
#define FRESH_IDS const int f_tid = fresh_tid(), f_lane = f_tid & 63, f_wave = __builtin_amdgcn_readfirstlane(f_tid >> 6); (void)f_lane; (void)f_wave
__device__ __forceinline__ float wave_sum(float v) {
#pragma unroll
    for (int o = 1; o < 64; o <<= 1) v += __shfl_xor(v, o);
    return v;
}

__device__ __forceinline__ void p0_transpose_item(const float* W, int ldw, int k0, int n0, bf16_t* WT, int ldt, int dest_row0, const float* gain, float scale, LAS float* scr, int lane) {
#pragma unroll 8
    for (int i = 0; i < 32; ++i) { const int kk = 2 * i + (lane >> 5); float v = W[(size_t)(k0 + kk) * ldw + n0 + (lane & 31)]; if (gain) v *= gain[k0 + kk]; scr[kk * 33 + (lane & 31)] = v * scale; }
    LDS_WAIT(); asm volatile("" ::: "memory");
    const int c = lane & 7;
#pragma unroll
    for (int j = 0; j < 4; ++j) { const int n = (lane >> 3) + 8 * j; const LAS float* s = scr + (8 * c) * 33 + n;
        u32x4 o; o.x = cvtpk(s[0 * 33], s[1 * 33]); o.y = cvtpk(s[2 * 33], s[3 * 33]); o.z = cvtpk(s[4 * 33], s[5 * 33]); o.w = cvtpk(s[6 * 33], s[7 * 33]);
        *(GAS u32x4*)(WT + (size_t)(dest_row0 + n) * ldt + k0 + 8 * c) = o; }
    LDS_WAIT(); asm volatile("" ::: "memory");
}
__device__ __forceinline__ int il_lo(int n) { return 256 * (n >> 7) + (n & 127); }

__device__ __forceinline__ double dexp_(double x) {
    const double n = __builtin_rint(x * 1.4426950408889634074), f = __builtin_fma(n, -0.693147180369123816490, x) + n * -1.90821492927058770002e-10;
    double p = 1.0 / 6227020800.0;
    p = p * f + 1.0 / 479001600.0; p = p * f + 1.0 / 39916800.0; p = p * f + 1.0 / 3628800.0; p = p * f + 1.0 / 362880.0; p = p * f + 1.0 / 40320.0; p = p * f + 1.0 / 5040.0;
    p = p * f + 1.0 / 720.0; p = p * f + 1.0 / 120.0; p = p * f + 1.0 / 24.0; p = p * f + 1.0 / 6.0; p = p * f + 0.5; p = p * f + 1.0; p = p * f + 1.0;
    const long long e = (long long)(1023 + (int)n) << 52; return p * __builtin_bit_cast(double, e);
}
__device__ __forceinline__ void dsincos_(double a, double& sn, double& cs) {
    const double rev = a * 0.15915494309189533577; const double r = rev - __builtin_rint(rev);
    const double q = __builtin_rint(4.0 * r), x = (r - 0.25 * q) * 6.28318530717958647692, x2 = x * x;
    double ps = -1.0 / 1307674368000.0; ps = ps * x2 + 1.0 / 6227020800.0; ps = ps * x2 - 1.0 / 39916800.0; ps = ps * x2 + 1.0 / 362880.0; ps = ps * x2 - 1.0 / 5040.0; ps = ps * x2 + 1.0 / 120.0; ps = ps * x2 - 1.0 / 6.0; ps = ps * x2 + 1.0; ps *= x;
    double pc = 1.0 / 20922789888000.0; pc = pc * x2 - 1.0 / 87178291200.0; pc = pc * x2 + 1.0 / 479001600.0; pc = pc * x2 - 1.0 / 3628800.0; pc = pc * x2 + 1.0 / 40320.0; pc = pc * x2 - 1.0 / 720.0; pc = pc * x2 + 1.0 / 24.0; pc = pc * x2 - 0.5; pc = pc * x2 + 1.0;
    const int qi = (int)q & 3;
    sn = (qi == 0) ? ps : (qi == 1) ? pc : (qi == 2) ? -ps : -pc;
    cs = (qi == 0) ? pc : (qi == 1) ? -ps : (qi == 2) ? -pc : ps;
}
__device__ __forceinline__ void ssm_prep_item(Frame& F, int g) {
    FRESH_IDS;
    LAS float* Pr = (LAS float*)F.lds;
    LAS float* Pi = Pr + 33 * 64;
    LAS float* Br = Pi + 33 * 64;
    LAS float* Bi = Br + 1024;
    LAS float* Cr = Bi + 1024;
    LAS float* Ci = Cr + 1024;
    LAS float* Kt = Ci + 1024;
    const float *lre = F.in[8], *lim = F.in[9], *ldt = F.in[10], *bre = F.in[11], *bim = F.in[12], *cre = F.in[13], *cim = F.in[14];
    const int tid = f_tid;
    const double dt = dexp_((double)ldt[g]);
    { const int p = tid & 63, dd = tid >> 6; const double lr = lre[g * 64 + p], li = lim[g * 64 + p];
        for (int d = dd; d <= 32; d += 8) { const double mg = dexp_(lr * dt * d); double sn, cs; dsincos_(li * dt * d, sn, cs); Pr[d * 64 + p] = (float)(mg * cs); Pi[d * 64 + p] = (float)(mg * sn); }
        if (dd == 0) { float* co = (float*)(F.ws + WS_COEF) + (g * 64 + p) * 4; const double m32 = dexp_(lr * dt * 32.0), m512 = dexp_(lr * dt * 512.0); double s32, c32, s512, c512; dsincos_(li * dt * 32.0, s32, c32); dsincos_(li * dt * 512.0, s512, c512);
            co[0] = (float)(m32 * c32); co[1] = (float)(m32 * s32); co[2] = (float)(m512 * c512); co[3] = (float)(m512 * s512); } }
#pragma unroll
    for (int e = 0; e < 2; ++e) { const int idx = tid * 2 + e, p = idx >> 4, h = idx & 15; const double lr = lre[g * 64 + p], li = lim[g * 64 + p];
        const double mg = dexp_(lr * dt); double s1, c1; dsincos_(li * dt, s1, c1); const double ar = mg * c1, ai = mg * s1, nr = ar - 1.0, ni = ai, den = lr * lr + li * li;
        const double fr = (nr * lr + ni * li) / den, fi = (ni * lr - nr * li) / den; const double br = bre[(g * 64 + p) * 16 + h], bi = bim[(g * 64 + p) * 16 + h];
        Br[p * 16 + h] = (float)(fr * br - fi * bi); Bi[p * 16 + h] = (float)(fr * bi + fi * br);
        const int c = idx >> 6, pc = idx & 63; Cr[c * 64 + pc] = cre[(g * 16 + c) * 64 + pc]; Ci[c * 64 + pc] = cim[(g * 16 + c) * 64 + pc]; }
    __syncthreads();
    for (int j = 0; j < 16; ++j) { const int v = tid + 512 * j, d = v >> 8, c = (v >> 4) & 15, h = v & 15; float s = 0.f;
        for (int p = 0; p < 64; ++p) { const float cr = Cr[c * 64 + p], ci = Ci[c * 64 + p], pr = Pr[d * 64 + p], pi = Pi[d * 64 + p];
            s += (cr * pr - ci * pi) * Br[p * 16 + h] - (cr * pi + ci * pr) * Bi[p * 16 + h]; }
        Kt[v] = s; }
    __syncthreads();
    bf16_t* TV = (bf16_t*)(F.ws + WS_TV) + (size_t)g * 512 * UK;
    for (int it = 0; it < 80; ++it) { const int id = tid + 512 * it, row = id / 80, q = id % 80, j = row >> 4, c = row & 15; float v[8];
        if (q < 64) { const int i = q >> 1, h0 = (q & 1) * 8;
#pragma unroll
            for (int e = 0; e < 8; ++e) v[e] = (j >= i) ? Kt[(j - i) * 256 + c * 16 + h0 + e] : 0.f; }
        else { const int p0 = ((q - 64) & 7) * 8; const bool im = q >= 72;
#pragma unroll
            for (int e = 0; e < 8; ++e) { const int p = p0 + e; const float cr = Cr[c * 64 + p], ci = Ci[c * 64 + p], pr = Pr[(j + 1) * 64 + p], pi = Pi[(j + 1) * 64 + p];
                v[e] = im ? -(cr * pi + ci * pr) : (cr * pr - ci * pi); } }
        u32x4 o; o.x = cvtpk(v[0], v[1]); o.y = cvtpk(v[2], v[3]); o.z = cvtpk(v[4], v[5]); o.w = cvtpk(v[6], v[7]);
        *(GAS u32x4*)(TV + (size_t)row * UK + q * 8) = o; }
    bf16_t* WL = (bf16_t*)(F.ws + WS_WLOC) + (size_t)g * 256 * 512;
    for (int it = 0; it < 32; ++it) { const int id = tid + 512 * it, row = id >> 6, q = id & 63; float v[8];
        if (row < 128) { const int ri = row >> 6, p = row & 63, i = q >> 1, h0 = (q & 1) * 8; const float pr = Pr[(31 - i) * 64 + p], pi = Pi[(31 - i) * 64 + p];
#pragma unroll
            for (int e = 0; e < 8; ++e) { const float br = Br[p * 16 + h0 + e], bi = Bi[p * 16 + h0 + e]; v[e] = ri ? (pr * bi + pi * br) : (pr * br - pi * bi); } }
        else {
#pragma unroll
            for (int e = 0; e < 8; ++e) v[e] = 0.f; }
        u32x4 o; o.x = cvtpk(v[0], v[1]); o.y = cvtpk(v[2], v[3]); o.z = cvtpk(v[4], v[5]); o.w = cvtpk(v[6], v[7]);
        *(GAS u32x4*)(WL + (size_t)row * 512 + q * 8) = o; }
    __syncthreads();
}

__device__ __forceinline__ void p0_prologue(Frame& F) {
    FRESH_IDS;
    if (F.vcu < 32) ssm_prep_item(F, F.vcu);
    LAS float* scr = (LAS float*)(F.lds + f_wave * 16384);
    const int gw = F.vcu * NWAVES + f_wave, NGW = F.G * NWAVES;
    constexpr int I_GU = 16 * 88, I_D = 44 * 32, I_IN = 16 * 128, I_AU = 8 * 32, I_GLU = 8 * 64, I_OUT = 16 * 32;
    constexpr int NITEMS = 4 * I_GU + 2 * I_D + I_IN + I_AU + I_GLU + I_OUT;
    unsigned char* ws = F.ws;
    for (int it = gw; it < NITEMS; it += NGW) {
        int r = it;
        if (r < 4 * I_GU) { const int which = r / I_GU; r -= which * I_GU; const int kb = r / 88, nb = r % 88;
            const float* W = which == 0 ? F.in[2] : which == 1 ? F.in[3] : which == 2 ? F.in[19] : F.in[20]; const float* gain = which < 2 ? F.in[1] : F.in[18];
            bf16_t* WT = (bf16_t*)(ws + (which < 2 ? WS_WGU1 : WS_WGU2));
            p0_transpose_item(W, DFF, 64 * kb, 32 * nb, WT, DM, il_lo(32 * nb) + ((which & 1) ? 128 : 0), gain, 1.f, scr, f_lane); continue; }
        r -= 4 * I_GU;
        if (r < 2 * I_D) { const int which = r / I_D; r -= which * I_D; const int kb = r / 32, nb = r % 32;
            p0_transpose_item(which ? F.in[21] : F.in[4], DM, 64 * kb, 32 * nb, (bf16_t*)(ws + (which ? WS_WD2 : WS_WD1)), DFF, 32 * nb, nullptr, 1.f, scr, f_lane); continue; }
        r -= 2 * I_D;
        if (r < I_IN) { const int kb = r / 128, nb = r % 128;
            p0_transpose_item(F.in[6], INW, 64 * kb, 32 * nb, (bf16_t*)(ws + WS_WIN), DM, 32 * nb, F.in[5], (32 * nb < AW) ? QSCALE : 1.f, scr, f_lane); continue; }
        r -= I_IN;
        if (r < I_AU) { const int kb = r / 32, nb = r % 32;
            p0_transpose_item(F.in[7], DM, 64 * kb, 32 * nb, (bf16_t*)(ws + WS_WAU), AW, 32 * nb, nullptr, 1.f, scr, f_lane); continue; }
        r -= I_AU;
        if (r < I_GLU) { const int kb = r / 64, nb = r % 64; const int n0 = 32 * nb;
            p0_transpose_item(F.in[16], 2048, 64 * kb, n0, (bf16_t*)(ws + WS_WGLU), SW, n0 < 1024 ? il_lo(n0) : il_lo(n0 - 1024) + 128, nullptr, 1.f, scr, f_lane); continue; }
        r -= I_GLU;
        { const int kb = r / 32, nb = r % 32;
            p0_transpose_item(F.in[17], DM, 64 * kb, 32 * nb, (bf16_t*)(ws + WS_WOUT), DM, 32 * nb, nullptr, 1.f, scr, f_lane); }
    }
    bf16_t* XB = (bf16_t*)(ws + WS_R1); float* SS = (float*)(ws + WS_SS);
    for (int m = gw; m < M; m += NGW) {
        const GAS f32x4* xr = (const GAS f32x4*)(F.in[0] + (size_t)m * DM) + f_lane; f32x4 v[4]; float s = 0.f;
#pragma unroll
        for (int j = 0; j < 4; ++j) { v[j] = xr[64 * j]; s += (v[j][0] * v[j][0] + v[j][1] * v[j][1]) + (v[j][2] * v[j][2] + v[j][3] * v[j][3]); }
        s = wave_sum(s);
        GAS u32x2* o8 = (GAS u32x2*)(XB + (size_t)m * DM) + f_lane;
#pragma unroll
        for (int j = 0; j < 4; ++j) { u32x2 w; w.x = cvtpk(v[j][0], v[j][1]); w.y = cvtpk(v[j][2], v[j][3]); o8[64 * j] = w; }
        if (f_lane < 16) SS[(size_t)m * 16 + f_lane] = (f_lane == 0) ? s : 0.f;
    }
}

__device__ __forceinline__ int crow(int r, int hi) { return (r & 3) + 8 * (r >> 2) + 4 * hi; }
constexpr int AL_K = 0, AL_V = 32768, AL_LIST = 65536  , AL_CNT = 81920, AL_WSF = 82432, AL_OST = 84480, AL_END = AL_OST + 8 * 4096;
static_assert(AL_END <= RING_BYTES, "attention LDS");
constexpr int A2_NR = 6;
__device__ __constant__ int A2_LO[A2_NR] = {1, 3, 5, 8, 13, 20}, A2_HI[A2_NR] = {2, 4, 7, 12, 19, 31}, A2_PRE[A2_NR + 1] = {0, 2, 6, 13, 25, 44, 75};
constexpr int A2_ITEMS = 75 * 16;

template <bool OWN>
__device__ __forceinline__ void attn_tile(LAS const unsigned char* KI, LAS const unsigned char* VI, const bf16_t* qrow, float bq, float slope2, int w, int lane, f32x16 (&o)[2], float& m_out, float& l_out) {
    const int r32 = lane & 31, hi = lane >> 5;
    bf16x8 qr[4];
#pragma unroll
    for (int d0 = 0; d0 < 4; ++d0) qr[d0] = *(const bf16x8*)(qrow + 16 * d0 + 8 * hi);
    f32x16 s[8];
    LAS const unsigned char* kp = KI + hi * 4096 + r32 * 16;
#pragma unroll
    for (int kt = 0; kt < 8; ++kt) {
        if (OWN && kt > w) {
#pragma unroll
            for (int r = 0; r < 16; ++r) s[kt][r] = -INFINITY;
        } else {
            const float b0 = bq + slope2 * (32.f * kt); f32x16 acc;
#pragma unroll
            for (int r = 0; r < 16; ++r) acc[r] = b0 + slope2 * (float)((r & 3) + 8 * (r >> 2)) + slope2 * 4.f * (float)hi;
#pragma unroll
            for (int d0 = 0; d0 < 4; ++d0) { const bf16x8 kf = *(LAS const bf16x8*)(kp + d0 * 8192 + kt * 512); acc = __builtin_amdgcn_mfma_f32_32x32x16_bf16(kf, qr[d0], acc, 0, 0, 0); }
            if (OWN && kt == w) {
#pragma unroll
                for (int r = 0; r < 16; ++r) if (crow(r, hi) > r32) acc[r] = -INFINITY;
            }
            s[kt] = acc;
        }
    }
    float m = s[0][0];
#pragma unroll
    for (int kt = 0; kt < 8; ++kt)
#pragma unroll
        for (int r = 0; r < 16; ++r) m = fmaxf(m, s[kt][r]);
    m = fmaxf(m, __shfl_xor(m, 32));
    float l = 0.f;
    u32x4 pw[8][2];
#pragma unroll
    for (int kt = 0; kt < 8; ++kt) {
        if (OWN && kt > w) { pw[kt][0] = (u32x4){0u, 0u, 0u, 0u}; pw[kt][1] = (u32x4){0u, 0u, 0u, 0u}; continue; }
        float p[16];
#pragma unroll
        for (int r = 0; r < 16; ++r) { p[r] = __builtin_amdgcn_exp2f(s[kt][r] - m); l += p[r]; }
#pragma unroll
        for (int s2 = 0; s2 < 2; ++s2) { pw[kt][s2].x = cvtpk(p[8 * s2 + 0], p[8 * s2 + 1]); pw[kt][s2].y = cvtpk(p[8 * s2 + 2], p[8 * s2 + 3]); pw[kt][s2].z = cvtpk(p[8 * s2 + 4], p[8 * s2 + 5]); pw[kt][s2].w = cvtpk(p[8 * s2 + 6], p[8 * s2 + 7]); }
        asm volatile("" : "+v"(pw[kt][0]), "+v"(pw[kt][1]));
    }
    l += __shfl_xor(l, 32);
    m_out = m; l_out = l;
    o[0] = f32x16{}; o[1] = f32x16{};
    LAS const unsigned char* vb = VI + ((lane >> 4) & 1) * 32 + (lane & 3) * 8 + (4 * hi + ((lane & 15) >> 2)) * 64;
#pragma unroll
    for (int kt = 0; kt < 8; ++kt) {
        if (OWN && kt > w) continue;
#pragma unroll
        for (int s2 = 0; s2 < 2; ++s2) {
            const bf16x8 pa = __builtin_bit_cast(bf16x8, pw[kt][s2]);
#pragma unroll
            for (int d0 = 0; d0 < 2; ++d0) {
                LAS const unsigned char* vp = vb + d0 * 16384 + (32 * kt + 16 * s2) * 64;
                const v4i16_t lo = __builtin_amdgcn_ds_read_tr16_b64_v4i16((LAS v4i16_t*)vp), hi4 = __builtin_amdgcn_ds_read_tr16_b64_v4i16((LAS v4i16_t*)(vp + 512));
                const bf16x8 vf = {lo[0], lo[1], lo[2], lo[3], hi4[0], hi4[1], hi4[2], hi4[3]};
                o[d0] = __builtin_amdgcn_mfma_f32_32x32x16_bf16(pa, vf, o[d0], 0, 0, 0);
            }
        }
    }
}
__device__ __forceinline__ void attn_stage(const f32x16 (&o)[2], float l, LAS float* wsf, LAS bf16_t* stg, int lane) {
    const int r32 = lane & 31, hi = lane >> 5;
    if (hi == 0) wsf[r32] = l;
#pragma unroll
    for (int r = 0; r < 16; ++r) { const int qr_ = crow(r, hi); const float rl = __builtin_amdgcn_rcpf(wsf[qr_]);
#pragma unroll
        for (int d0 = 0; d0 < 2; ++d0) { const unsigned w = cvtpk(o[d0][r] * rl, 0.f); stg[qr_ * 64 + d0 * 32 + r32] = (bf16_t)(w & 0xffffu); } }
}
__device__ __forceinline__ void load_kv_images(Frame& F, int f_tid, int f_wave, const bf16_t* kimg, const bf16_t* vimg) {
#pragma unroll
    for (int i = 0; i < 4; ++i) {
        __builtin_amdgcn_global_load_lds((const unsigned*)((const char*)kimg + (size_t)(i * 512 + f_tid) * 16), (LAS unsigned*)(F.lds + AL_K + (i * 512 + f_wave * 64) * 16), 16, 0, 0);
        __builtin_amdgcn_global_load_lds((const unsigned*)((const char*)vimg + (size_t)(i * 512 + f_tid) * 16), (LAS unsigned*)(F.lds + AL_V + (i * 512 + f_wave * 64) * 16), 16, 0, 0);
    }
}

__device__ __forceinline__ void a1_topk(Frame& F) {
    FRESH_IDS;
    LAS float* km = (LAS float*)F.lds;
    const float* KMP = (const float*)(F.ws + WS_KMP); const bf16_t* Q = (const bf16_t*)(F.ws + WS_Q); unsigned* SEL = (unsigned*)(F.ws + WS_SEL);
    for (int it = F.vcu; it < 256; it += F.G) {
        const int bh = it >> 4, seg = it & 15, b = bh >> 3, h = bh & 7;
        __syncthreads();
        for (int e = f_tid; e < 2048; e += NTHR) { const int n = e >> 6, d = e & 63; km[e] = (KMP[((size_t)(bh * NBLK + n) * 2 + 0) * HD + d] + KMP[((size_t)(bh * NBLK + n) * 2 + 1) * HD + d]) * (1.0f / MBLK); }
        __syncthreads();
        const int t = seg * 512 + f_tid, blk = t >> 8;
        const u32x4* qp = (const u32x4*)(Q + ((size_t)(b * SEQ + t)) * AW + h * HD);
        float q[64];
#pragma unroll
        for (int i = 0; i < 8; ++i) { const u32x4 w = qp[i]; q[8 * i + 0] = bf_lo(w.x); q[8 * i + 1] = bf_hi(w.x); q[8 * i + 2] = bf_lo(w.y); q[8 * i + 3] = bf_hi(w.y); q[8 * i + 4] = bf_lo(w.z); q[8 * i + 5] = bf_hi(w.z); q[8 * i + 6] = bf_lo(w.w); q[8 * i + 7] = bf_hi(w.w); }
        float v0 = -INFINITY, v1 = -INFINITY, v2 = -INFINITY; unsigned i0 = 255u, i1 = 255u, i2 = 255u;
        for (int n = 0; n < blk; ++n) { float g = 0.f;
#pragma unroll
            for (int d4 = 0; d4 < 16; ++d4) { const f32x4 kk = *(LAS const f32x4*)(km + n * 64 + d4 * 4); g = fmaf(q[4 * d4], kk[0], g); g = fmaf(q[4 * d4 + 1], kk[1], g); g = fmaf(q[4 * d4 + 2], kk[2], g); g = fmaf(q[4 * d4 + 3], kk[3], g); }
            if (g > v0) { v2 = v1; i2 = i1; v1 = v0; i1 = i0; v0 = g; i0 = (unsigned)n; }
            else if (g > v1) { v2 = v1; i2 = i1; v1 = g; i1 = (unsigned)n; }
            else if (g > v2) { v2 = g; i2 = (unsigned)n; } }
        SEL[(size_t)bh * SEQ + t] = i0 | (i1 << 8) | (i2 << 16);
    }
    __syncthreads();
}

__device__ __forceinline__ void a2_gathered(Frame& F, int first_item_delay) {
    FRESH_IDS;
    const bf16_t* Q = (const bf16_t*)(F.ws + WS_Q); const bf16_t* KI = (const bf16_t*)(F.ws + WS_K); const bf16_t* VI = (const bf16_t*)(F.ws + WS_V);
    const unsigned* SEL = (const unsigned*)(F.ws + WS_SEL); bf16_t* OP = (bf16_t*)(F.ws + WS_OPART); float* LP = (float*)(F.ws + WS_LPART);
    LAS unsigned* list = (LAS unsigned*)(F.lds + AL_LIST); LAS unsigned* cntp = (LAS unsigned*)(F.lds + AL_CNT);
    LAS float* wsf = (LAS float*)(F.lds + AL_WSF) + f_wave * 64; LAS bf16_t* stg = (LAS bf16_t*)(F.lds + AL_OST + f_wave * 4096);
    const int lane = f_lane, r32 = lane & 31, hi = lane >> 5;
    (void)first_item_delay;
    for (int it = F.vcu; it < A2_ITEMS; it += F.G) {
        const int bh = it & 15, j = it >> 4; int rg = 0;
#pragma unroll
        for (int k = 1; k < A2_NR; ++k) if (j >= A2_PRE[k]) rg = k;
        const int n = j - A2_PRE[rg], qb_lo = (A2_LO[rg] > n + 1) ? A2_LO[rg] : n + 1, qb_hi = A2_HI[rg];
        const int b = bh >> 3, h = bh & 7; const float slope2 = exp2f(-(float)(h + 1)) * LOG2E;
        if (f_tid == 0) cntp[0] = 0u;
        load_kv_images(F, f_tid, f_wave, KI + (size_t)(bh * NBLK + n) * (MBLK * HD), VI + (size_t)(bh * NBLK + n) * (MBLK * HD));
        __syncthreads();
        for (int t0 = qb_lo * MBLK; t0 < (qb_hi + 1) * MBLK; t0 += NTHR) {
            const int t = t0 + f_tid; int rank = -1;
            if (t < (qb_hi + 1) * MBLK) { const unsigned wv = SEL[(size_t)bh * SEQ + t]; rank = ((wv & 255u) == (unsigned)n) ? 0 : (((wv >> 8) & 255u) == (unsigned)n) ? 1 : (((wv >> 16) & 255u) == (unsigned)n) ? 2 : -1; }
            const unsigned long long bal = __ballot(rank >= 0);
            unsigned base = 0u;
            if (lane == 0 && bal) base = __hip_atomic_fetch_add(cntp, (unsigned)__popcll(bal), __ATOMIC_RELAXED, __HIP_MEMORY_SCOPE_WORKGROUP);
            base = (unsigned)__builtin_amdgcn_readfirstlane((int)base);
            if (rank >= 0) list[base + (unsigned)__popcll(bal & ((1ull << lane) - 1ull))] = (unsigned)t | ((unsigned)rank << 16);
        }
        VM_WAIT();
        __syncthreads();
        const int cnt = (int)cntp[0];
        LAS const unsigned char* KL = F.lds + AL_K; LAS const unsigned char* VL = F.lds + AL_V;
        for (int tile = f_wave; tile * 32 < cnt; tile += NWAVES) {
            const int idx = tile * 32 + r32; const unsigned e = list[idx < cnt ? idx : 0]; const int t = (int)(e & 0xffffu);
            f32x16 o[2]; float m, l;
            attn_tile<false>(KL, VL, Q + ((size_t)(b * SEQ + t)) * AW + h * HD, slope2 * (float)(n * MBLK - t), slope2, 0, lane, o, m, l);
            attn_stage(o, l, wsf, stg, lane);
            if (hi == 0 && idx < cnt) LP[((size_t)bh * SEQ + t) * 4 + (e >> 16)] = m + __builtin_amdgcn_logf(l);
#pragma unroll
            for (int i = 0; i < 4; ++i) { const int row = i * 8 + (lane >> 3), ch = lane & 7, id2 = tile * 32 + row;
                if (id2 < cnt) { const unsigned e2 = list[id2]; const u32x4 v = *(LAS const u32x4*)(stg + row * 64 + ch * 8);
                    *(u32x4*)(OP + (((size_t)bh * SEQ + (e2 & 0xffffu)) * 3 + (e2 >> 16)) * HD + ch * 8) = v; } }
        }
        __syncthreads();
    }
}

__device__ __forceinline__ void a3_own_item(Frame& F, int it) {
    FRESH_IDS;
    bf16_t* Q = (bf16_t*)(F.ws + WS_Q); const bf16_t* KI = (const bf16_t*)(F.ws + WS_K); const bf16_t* VI = (const bf16_t*)(F.ws + WS_V);
    const bf16_t* OP = (const bf16_t*)(F.ws + WS_OPART); const float* LP = (const float*)(F.ws + WS_LPART);
    LAS float* wsf = (LAS float*)(F.lds + AL_WSF) + f_wave * 64; LAS bf16_t* stg = (LAS bf16_t*)(F.lds + AL_OST + f_wave * 4096);
    const int lane = f_lane, r32 = lane & 31, hi = lane >> 5, w = f_wave;
    const int bh = it >> 5, qb = it & 31, b = bh >> 3, h = bh & 7; const float slope2 = exp2f(-(float)(h + 1)) * LOG2E;
    load_kv_images(F, f_tid, f_wave, KI + (size_t)(bh * NBLK + qb) * (MBLK * HD), VI + (size_t)(bh * NBLK + qb) * (MBLK * HD));
    VM_WAIT();
    __syncthreads();
    const int t = qb * MBLK + w * 32 + r32;
    f32x16 o[2]; float m, l;
    attn_tile<true>(F.lds + AL_K, F.lds + AL_V, Q + ((size_t)(b * SEQ + t)) * AW + h * HD, slope2 * (float)(qb * MBLK - t), slope2, w, lane, o, m, l);
    attn_stage(o, l, wsf, stg, lane);
    if (hi == 0) wsf[32 + r32] = m + __builtin_amdgcn_logf(l);
    const int nv = qb < 3 ? qb : 3;
#pragma unroll
    for (int i = 0; i < 4; ++i) { const int row = i * 8 + (lane >> 3), ch = lane & 7, t2 = qb * MBLK + w * 32 + row;
        const u32x4 ow = *(LAS const u32x4*)(stg + row * 64 + ch * 8); const float lo = wsf[32 + row];
        float ls[3]; float mx = lo;
#pragma unroll
        for (int k = 0; k < 3; ++k) { ls[k] = (k < nv) ? LP[((size_t)bh * SEQ + t2) * 4 + k] : -INFINITY; mx = fmaxf(mx, ls[k]); }
        float wo = __builtin_amdgcn_exp2f(lo - mx), den = wo; float acc[8] = {bf_lo(ow.x) * wo, bf_hi(ow.x) * wo, bf_lo(ow.y) * wo, bf_hi(ow.y) * wo, bf_lo(ow.z) * wo, bf_hi(ow.z) * wo, bf_lo(ow.w) * wo, bf_hi(ow.w) * wo};
#pragma unroll
        for (int k = 0; k < 3; ++k) if (k < nv) { const float wk = __builtin_amdgcn_exp2f(ls[k] - mx); den += wk; const u32x4 pw = *(const u32x4*)(OP + (((size_t)bh * SEQ + t2) * 3 + k) * HD + ch * 8);
            acc[0] += wk * bf_lo(pw.x); acc[1] += wk * bf_hi(pw.x); acc[2] += wk * bf_lo(pw.y); acc[3] += wk * bf_hi(pw.y); acc[4] += wk * bf_lo(pw.z); acc[5] += wk * bf_hi(pw.z); acc[6] += wk * bf_lo(pw.w); acc[7] += wk * bf_hi(pw.w); }
        const float rd = 1.0f / den; u32x4 ov; ov.x = cvtpk(acc[0] * rd, acc[1] * rd); ov.y = cvtpk(acc[2] * rd, acc[3] * rd); ov.z = cvtpk(acc[4] * rd, acc[5] * rd); ov.w = cvtpk(acc[6] * rd, acc[7] * rd);
        *(u32x4*)(Q + ((size_t)(b * SEQ + t2)) * AW + h * HD + ch * 8) = ov; }
    __syncthreads();
}

__device__ __forceinline__ void scan_item(Frame& F, int it) {
    FRESH_IDS;
    LAS float* Er = (LAS float*)F.lds; LAS float* Ei = Er + 512;
    const float* SL = (const float*)(F.ws + WS_SLOC); const float* CO = (const float*)(F.ws + WS_COEF); bf16_t* UX = (bf16_t*)(F.ws + WS_UEXT);
    const int s = f_tid >> 5, l = f_tid & 31, idx = it * 32 + l, b = idx >> 11, g = (idx >> 6) & 31, p = idx & 63;
    const f32x4 co = *(const f32x4*)(CO + (g * 64 + p) * 4); const float ar = co[0], ai = co[1], a16r = co[2], a16i = co[3];
    const size_t c0 = (size_t)g * NCHUNK + b * 256 + s * 16;
    float pr[16], pi[16]; float hr = 0.f, hq = 0.f;
#pragma unroll
    for (int j = 0; j < 16; ++j) { pr[j] = hr; pi[j] = hq; const float sr = SL[(c0 + j) * 128 + p], si = SL[(c0 + j) * 128 + 64 + p];
        const float nr = ar * hr - ai * hq + sr, ni = ar * hq + ai * hr + si; hr = nr; hq = ni; }
    __syncthreads();
    Er[s * 32 + l] = hr; Ei[s * 32 + l] = hq;
    __syncthreads();
    float cr = 0.f, ci = 0.f;
    for (int s2 = 0; s2 < s; ++s2) { const float er = Er[s2 * 32 + l], ei = Ei[s2 * 32 + l]; const float nr = a16r * cr - a16i * ci + er, ni = a16r * ci + a16i * cr + ei; cr = nr; ci = ni; }
#pragma unroll
    for (int j = 0; j < 16; ++j) { const float orr = cr + pr[j], oi = ci + pi[j];
        bf16_t* dst = UX + (c0 + j) * UK + 512 + p; dst[0] = (bf16_t)(cvtpk(orr, 0.f) & 0xffffu); dst[64] = (bf16_t)(cvtpk(oi, 0.f) & 0xffffu);
        const float nr = ar * cr - ai * ci, ni = ar * ci + ai * cr; cr = nr; ci = ni; }
    __syncthreads();
}

__device__ __forceinline__ void final_norm(Frame& F) {
    FRESH_IDS;
    const float* SS = (const float*)(F.ws + WS_SS); const float* gf = F.in[22];
    const int gw = F.vcu * NWAVES + f_wave, NGW = F.G * NWAVES;
    f32x4 gv[4];
#pragma unroll
    for (int j = 0; j < 4; ++j) gv[j] = *((const f32x4*)gf + f_lane + 64 * j);
    for (int m = gw; m < M; m += NGW) {
        float s = (f_lane < 16) ? SS[(size_t)m * 16 + f_lane] : 0.f; s = wave_sum(s);
        const float rs = 1.0f / sqrtf(s * (1.0f / DM) + EPS);
        f32x4* xr = (f32x4*)(F.out + (size_t)m * DM) + f_lane;
#pragma unroll
        for (int j = 0; j < 4; ++j) { f32x4 v = xr[64 * j]; v = v * rs * gv[j]; xr[64 * j] = v; }
    }
}
constexpr int NPH = 13;
struct Args { const float* in[23]; float* out; unsigned char* ws; int ph_lo, ph_hi; };
__global__ void __launch_bounds__(NTHR, 2) mk_fwd(Args args) {
    extern __shared__ __attribute__((aligned(16))) unsigned char lds[];
    Frame F;
    F.lds = (LAS unsigned char*)lds;
    F.G = gridDim.x; { const int bx = blockIdx.x; F.vcu = (F.G % 8 == 0) ? (bx % 8) * (F.G / 8) + bx / 8 : bx; }
    F.ws = args.ws; F.out = args.out;
#define CP(i) F.in[i] = args.in[i];
    CP(0) CP(1) CP(2) CP(3) CP(4) CP(5) CP(6) CP(7) CP(8) CP(9) CP(10) CP(11) CP(12) CP(13) CP(14) CP(15) CP(16) CP(17) CP(18) CP(19) CP(20) CP(21) CP(22)
#undef CP
    for (int u = threadIdx.x; u < (LDS_BYTES - LDSCTL_OFF) / 4; u += NTHR) ((LAS unsigned*)(F.lds + LDSCTL_OFF))[u] = 0u;
    __syncthreads();
    volatile LAS unsigned* MISC = (volatile LAS unsigned*)(F.lds + MISC_OFF);
    XcdBarrier bar = xcd_barrier_post((unsigned*)(F.ws + WS_CTL) + CW_BAR, MISC + 8);
    const int lo = args.ph_lo, hi = args.ph_hi, bx = (int)blockIdx.x;
    unsigned char* ws = F.ws;
    float* SS = (float*)(ws + WS_SS);
#define IN(k) (lo <= (k) && (k) < hi)
#define SEAM(k) do { if (IN(k) && IN((k) + 1)) xcd_barrier(bar); } while (0)
#define RUN_GEMM(g, S, E) pg8::gemm_phase<true, true>(F.lds, g, S, E)

    if (IN(0)) { p0_prologue(F); } SEAM(0);

    if (IN(1)) {
        pg8::Gemm g{(const bf16_t*)(ws + WS_R1), (const bf16_t*)(ws + WS_WGU1), DM, DM, DM, 0, 0}; pg8::Order S; S.init(M / 256, 2 * DFF / 256, 1, F.G, bx);
        pg8::Epi E{}; E.mode = pg8::EP_SWIGLU; E.perm = true; E.ss = SS; E.O = (bf16_t*)(ws + WS_ACT);
        RUN_GEMM(g, S, E);
    } SEAM(1);
    if (IN(2)) {
        pg8::Gemm g{(const bf16_t*)(ws + WS_ACT), (const bf16_t*)(ws + WS_WD1), DFF, DFF, DFF, 0, 0}; pg8::Order S; S.init(M / 256, DM / 256, 1, F.G, bx);
        pg8::Epi E{}; E.mode = pg8::EP_RESID; E.perm = false; E.R = F.in[0]; E.out = F.out; E.xb = (bf16_t*)(ws + WS_R1); E.ss_out = SS; E.alpha = 0.5f;
        RUN_GEMM(g, S, E);
    } SEAM(2);
    if (IN(3)) {
        pg8::Gemm g{(const bf16_t*)(ws + WS_R1), (const bf16_t*)(ws + WS_WIN), DM, DM, DM, 0, 0}; pg8::Order S; S.init(M / 256, 2048 / 256, 1, F.G, bx);
        pg8::Epi E{}; E.mode = pg8::EP_PROJ; E.perm = true; E.ss = SS; E.Q = (bf16_t*)(ws + WS_Q); E.Kimg = (bf16_t*)(ws + WS_K); E.Vimg = (bf16_t*)(ws + WS_V); E.uext = (bf16_t*)(ws + WS_UEXT); E.kmp = (float*)(ws + WS_KMP);
        RUN_GEMM(g, S, E);
    } SEAM(3);
    if (IN(4)) {
        a1_topk(F);
        pg8::Gemm g{(const bf16_t*)(ws + WS_UEXT), (const bf16_t*)(ws + WS_WLOC), UK, 512, 512, (size_t)NCHUNK * UK * 2, (size_t)256 * 512 * 2}; pg8::Order S; S.init(2, 1, 32, F.G, bx);
        pg8::Epi E{}; E.mode = pg8::EP_SLOC; E.perm = false; E.sloc = (float*)(ws + WS_SLOC);
        RUN_GEMM(g, S, E);
    } SEAM(4);
    if (IN(5)) {
        for (int it = F.vcu; it < 128; it += F.G) scan_item(F, it);
        a2_gathered(F, 0);
    } SEAM(5);
    if (IN(6)) {
        { pg8::Gemm g{(const bf16_t*)(ws + WS_UEXT), (const bf16_t*)(ws + WS_TV), UK, UK, UK, (size_t)NCHUNK * UK * 2, (size_t)512 * UK * 2}; pg8::Order S; S.init(2, 2, 32, F.G, bx);
          pg8::Epi E{}; E.mode = pg8::EP_Y; E.perm = true; E.O = (bf16_t*)(ws + WS_GY); E.uext = (bf16_t*)(ws + WS_UEXT); E.dsk = F.in[15];
          RUN_GEMM(g, S, E); }
        if (F.G == 256) { if (bx < 128) a3_own_item(F, bx); else { for (int k = 0; k < 3; ++k) a3_own_item(F, 128 + (bx - 128) * 3 + k); } }
        else { for (int it = bx; it < 512; it += F.G) a3_own_item(F, it); }
    } SEAM(6);
    if (IN(7)) {
        { pg8::Gemm g{(const bf16_t*)(ws + WS_Q), (const bf16_t*)(ws + WS_WAU), AW, AW, AW, 0, 0}; pg8::Order S; S.init(M / 256, DM / 256, 1, F.G, bx);
          pg8::Epi E{}; E.mode = pg8::EP_BF16; E.perm = true; E.O = (bf16_t*)(ws + WS_AUP);
          RUN_GEMM(g, S, E); }
        { pg8::Gemm g{(const bf16_t*)(ws + WS_R1), (const bf16_t*)(ws + WS_WIN) + (size_t)2048 * DM, DM, DM, DM, 0, 0}; pg8::Order S; S.init(M / 256, 2048 / 256, 1, F.G, bx);
          pg8::Epi E{}; E.mode = pg8::EP_GATES; E.perm = true; E.ss = SS; E.O = (bf16_t*)(ws + WS_SGA); E.O2 = (bf16_t*)(ws + WS_SGS);
          RUN_GEMM(g, S, E); }
    } SEAM(7);
    if (IN(8)) {
        pg8::Gemm g{(const bf16_t*)(ws + WS_GY), (const bf16_t*)(ws + WS_WGLU), SW, SW, SW, 0, 0}; pg8::Order S; S.init(M / 256, 2048 / 256, 1, F.G, bx);
        pg8::Epi E{}; E.mode = pg8::EP_MERGE; E.perm = true; E.O = (bf16_t*)(ws + WS_R1); E.aup = (const bf16_t*)(ws + WS_AUP); E.sga = (const bf16_t*)(ws + WS_SGA); E.sgs = (const bf16_t*)(ws + WS_SGS);
        RUN_GEMM(g, S, E);
    } SEAM(8);
    if (IN(9)) {
        pg8::Gemm g{(const bf16_t*)(ws + WS_R1), (const bf16_t*)(ws + WS_WOUT), DM, DM, DM, 0, 0}; pg8::Order S; S.init(M / 256, DM / 256, 1, F.G, bx);
        pg8::Epi E{}; E.mode = pg8::EP_RESID; E.perm = false; E.R = F.out; E.out = F.out; E.xb = (bf16_t*)(ws + WS_X2B); E.ss_out = SS; E.alpha = 1.0f;
        RUN_GEMM(g, S, E);
    } SEAM(9);
    if (IN(10)) {
        pg8::Gemm g{(const bf16_t*)(ws + WS_X2B), (const bf16_t*)(ws + WS_WGU2), DM, DM, DM, 0, 0}; pg8::Order S; S.init(M / 256, 2 * DFF / 256, 1, F.G, bx);
        pg8::Epi E{}; E.mode = pg8::EP_SWIGLU; E.perm = true; E.ss = SS; E.O = (bf16_t*)(ws + WS_ACT);
        RUN_GEMM(g, S, E);
    } SEAM(10);
    if (IN(11)) {
        pg8::Gemm g{(const bf16_t*)(ws + WS_ACT), (const bf16_t*)(ws + WS_WD2), DFF, DFF, DFF, 0, 0}; pg8::Order S; S.init(M / 256, DM / 256, 1, F.G, bx);
        pg8::Epi E{}; E.mode = pg8::EP_RESID; E.perm = false; E.R = F.out; E.out = F.out; E.xb = nullptr; E.ss_out = SS; E.alpha = 0.5f;
        RUN_GEMM(g, S, E);
    } SEAM(11);
    if (IN(12)) { final_norm(F); }
#undef IN
#undef SEAM
#undef RUN_GEMM
}

#ifndef HYB
#define HYB 0
#endif
#if HYB

__global__ void bf2f_k(const bf16_t* in, float* out, size_t n) { size_t i = (size_t)blockIdx.x * blockDim.x + threadIdx.x; if (i < n) out[i] = __uint_as_float((unsigned)in[i] << 16); }
static void v1gemm(hipStream_t st, const float* A, int lda, const float* B, int ldb, float* C, int ldc, int Mr, int N, int K) { sgemm_k<0><<<dim3(N / 128, Mr / 128), 256, 0, st>>>(A, lda, B, ldb, C, ldc, K, nullptr, 0, 0.f); }
static void v1gemm_res(hipStream_t st, const float* A, int lda, const float* B, int ldb, float* C, int ldc, int Mr, int N, int K, const float* R, int ldr, float alpha) { sgemm_k<1><<<dim3(N / 128, Mr / 128), 256, 0, st>>>(A, lda, B, ldb, C, ldc, K, R, ldr, alpha); }
#endif
#ifndef USE_MK_ATTN
#define USE_MK_ATTN 1
#endif
#ifndef USE_MK_GY
#define USE_MK_GY 1
#endif

extern "C" void kernel_launch(void* const* d_in, const int* in_sizes, int n_in, void* d_out, int out_size, void* d_ws, size_t ws_size, hipStream_t stream) {
    static int grid = 0;
    if (grid == 0) {
        if (n_in != 23 || in_sizes[0] != M * DM || out_size != M * DM || ws_size < WS_END) { fprintf(stderr, "kernel_launch: unexpected shapes (n_in %d in0 %d out %d ws %zu)\n", n_in, n_in > 0 ? in_sizes[0] : -1, out_size, ws_size); grid = -1; return; }
        int dev = 0, cus = 0, per_cu = 0;
        if (hipGetDevice(&dev) != hipSuccess || hipDeviceGetAttribute(&cus, hipDeviceAttributeMultiprocessorCount, dev) != hipSuccess) { grid = -1; return; }
        if (hipFuncSetAttribute((const void*)mk_fwd, hipFuncAttributeMaxDynamicSharedMemorySize, LDS_BYTES) != hipSuccess) { fprintf(stderr, "kernel_launch: hipFuncSetAttribute failed\n"); grid = -1; return; }
        if (hipOccupancyMaxActiveBlocksPerMultiprocessor(&per_cu, (const void*)mk_fwd, NTHR, LDS_BYTES) != hipSuccess || per_cu < 1) fprintf(stderr, "kernel_launch: occupancy query says %d blocks/CU\n", per_cu);
        (void)hipGetLastError();
        grid = cus;
    }
    if (grid < 0) return;
    (void)hipMemsetAsync((char*)d_ws + WS_CTL, 0, CTL_ZERO_BYTES, stream);
    Args a{};
    for (int i = 0; i < 23; ++i) a.in[i] = (const float*)d_in[i];
    a.out = (float*)d_out; a.ws = (unsigned char*)d_ws;
    a.ph_lo = 0;
    a.ph_hi = (HYB == 0) ? NPH : (HYB == 1) ? 3 : (HYB == 2) ? 7 : 10;
    hipLaunchKernelGGL(mk_fwd, dim3(grid), dim3(NTHR), LDS_BYTES, stream, a);
#if HYB
    const float* x = (const float*)d_in[0]; (void)x;
    const float* nm = (const float*)d_in[5]; const float* win = (const float*)d_in[6]; const float* wau = (const float*)d_in[7];
    const float *lre = (const float*)d_in[8], *lim = (const float*)d_in[9], *ldt = (const float*)d_in[10];
    const float *bre = (const float*)d_in[11], *bim = (const float*)d_in[12], *cre = (const float*)d_in[13], *cim = (const float*)d_in[14], *dsk = (const float*)d_in[15];
    const float* wglu = (const float*)d_in[16]; const float* wout = (const float*)d_in[17]; const float* n2 = (const float*)d_in[18];
    const float *wg2 = (const float*)d_in[19], *wu2 = (const float*)d_in[20], *wd2 = (const float*)d_in[21]; const float* nf = (const float*)d_in[22];
    float* out = (float*)d_out; float* ws = (float*)d_ws;
    size_t off = 0; auto take = [&](size_t n) { float* p = ws + off; off += (n + 63) & ~(size_t)63; return p; };
    float* hc = take((size_t)CH * 1024); float* G = take((size_t)CH * DFF); float* U = take((size_t)CH * DFF);
    float* qc = take((size_t)CH * AW); float* ac = take((size_t)CH * AW); float* aup = take((size_t)CH * 1024);
    float* ga = take((size_t)CH * 1024); float* gs = take((size_t)CH * 1024); float* glu = take((size_t)CH * 2048); float* mg = take((size_t)CH * 1024);
    float* kmean = take(BATCH * NH * NBLK * HD); float* abr = take(2048); float* abi = take(2048); float* bbr = take(2048 * 16); float* bbi = take(2048 * 16);
    if (off * 4 > 110 * MiB) { fprintf(stderr, "hybrid scratch too large\n"); return; }
    float* kb = (float*)((char*)d_ws + 126 * MiB); float* vb = kb + (size_t)MTOK * AW; float* ub = vb + (size_t)MTOK * AW;
    const size_t nact = (size_t)CH * DFF;
#if HYB <= 2
    for (int r0 = 0; r0 < MTOK; r0 += CH) {
        float* x1 = out + (size_t)r0 * 1024;
        rmsnorm_k<<<CH, 256, 0, stream>>>(x1, nm, hc);
        v1gemm(stream, hc, 1024, win + 512, INW, kb + (size_t)r0 * AW, AW, CH, AW, 1024);
        v1gemm(stream, hc, 1024, win + 1024, INW, vb + (size_t)r0 * AW, AW, CH, AW, 1024);
        v1gemm(stream, hc, 1024, win + 1536, INW, ub + (size_t)r0 * AW, AW, CH, AW, 1024);
    }
    kmean_k<<<dim3(NBLK, NH, BATCH), 64, 0, stream>>>(kb, kmean);
    ssm_prep_k<<<8, 256, 0, stream>>>(lre, lim, ldt, bre, bim, abr, abi, bbr, bbi);
    ssm_scan_k<<<dim3(32, BATCH), 64, 0, stream>>>(ub, abr, abi, bbr, bbi, cre, cim, dsk);
#endif
    for (int r0 = 0; r0 < MTOK; r0 += CH) {
        float* x1 = out + (size_t)r0 * 1024;
#if HYB <= 2
        rmsnorm_k<<<CH, 256, 0, stream>>>(x1, nm, hc);
        v1gemm(stream, hc, 1024, win, INW, qc, AW, CH, AW, 1024);
        v1gemm(stream, hc, 1024, win + 2048, INW, ga, 1024, CH, 1024, 1024);
        v1gemm(stream, hc, 1024, win + 3072, INW, gs, 1024, CH, 1024, 1024);
        if (HYB == 2 && USE_MK_ATTN) bf2f_k<<<(CH * AW + 255) / 256, 256, 0, stream>>>((const bf16_t*)((char*)d_ws + WS_Q) + (size_t)r0 * AW, ac, (size_t)CH * AW);
        else attn_naive_k<<<dim3(CH / 4, NH), 256, 0, stream>>>(qc, r0, kb, vb, kmean, ac);
        v1gemm(stream, ac, AW, wau, 1024, aup, 1024, CH, 1024, AW);
        if (HYB == 2 && USE_MK_GY) bf2f_k<<<(CH * SW + 255) / 256, 256, 0, stream>>>((const bf16_t*)((char*)d_ws + WS_GY) + (size_t)r0 * SW, qc, (size_t)CH * SW);
        else gelu_k<<<(CH * SW + 255) / 256, 256, 0, stream>>>(ub + (size_t)r0 * SW, qc, (size_t)CH * SW);
        v1gemm(stream, qc, SW, wglu, 2048, glu, 2048, CH, 2048, SW);
        merge_k<<<(CH * 1024 + 255) / 256, 256, 0, stream>>>(ga, gs, aup, glu, mg, CH);
        v1gemm_res(stream, mg, 1024, wout, 1024, x1, 1024, CH, 1024, 1024, x1, 1024, 1.0f);
#endif
        rmsnorm_k<<<CH, 256, 0, stream>>>(x1, n2, hc);
        v1gemm(stream, hc, 1024, wg2, DFF, G, DFF, CH, DFF, 1024);
        v1gemm(stream, hc, 1024, wu2, DFF, U, DFF, CH, DFF, 1024);
        swiglu_k<<<(unsigned)((nact + 255) / 256), 256, 0, stream>>>(G, U, nact);
        v1gemm_res(stream, G, DFF, wd2, 1024, x1, 1024, CH, 1024, DFF, x1, 1024, 0.5f);
        rmsnorm_k<<<CH, 256, 0, stream>>>(x1, nf, x1);
    }
#endif
}
```

```cpp
#include <hip/hip_runtime.h>
#include <cstdio>
#include <cstdint>
#include <cmath>

#define LAS __attribute__((address_space(3)))
#define GAS __attribute__((address_space(1)))
typedef unsigned short bf16_t;
typedef short bf16x8 __attribute__((ext_vector_type(8)));
typedef short v4i16_t __attribute__((ext_vector_type(4)));
typedef float f32x2 __attribute__((ext_vector_type(2)));
typedef float f32x4 __attribute__((ext_vector_type(4)));
typedef float f32x16 __attribute__((ext_vector_type(16)));
typedef unsigned u32x2 __attribute__((ext_vector_type(2)));
typedef unsigned u32x4 __attribute__((ext_vector_type(4)));
typedef __bf16 bf16x2_t __attribute__((ext_vector_type(2)));

constexpr int BATCH = 2, SEQ = 8192, DM = 1024, M = BATCH * SEQ;
constexpr int NH = 8, HD = 64, AW = 512, MBLK = 256, NBLK = 32;
constexpr int SW = 512, DFF = 2816, INW = 4096;
constexpr int SCH = 32, NCHUNK = M / SCH  , UK = 640  ;
constexpr float EPS = 1e-6f;
constexpr float LOG2E = 1.4426950408889634f;
constexpr float QSCALE = 0.125f * LOG2E;

__device__ __forceinline__ unsigned cvtpk(float lo, float hi) { f32x2 v = {lo, hi}; bf16x2_t b = __builtin_convertvector(v, bf16x2_t); return __builtin_bit_cast(unsigned, b); }
__device__ __forceinline__ float bf_lo(unsigned w) { return __uint_as_float(w << 16); }
__device__ __forceinline__ float bf_hi(unsigned w) { return __uint_as_float(w & 0xffff0000u); }
__device__ __forceinline__ float fast_sigmoid(float x) { return __builtin_amdgcn_rcpf(1.0f + __builtin_amdgcn_exp2f(-LOG2E * x)); }
__device__ __forceinline__ float gelu_tanh_f(float x) {
    const float z = 0.7978845608028654f * (x + 0.044715f * x * x * x);
    return x * __builtin_amdgcn_rcpf(1.0f + __builtin_amdgcn_exp2f(-2.0f * LOG2E * z));
}

namespace pg8 {
constexpr int BM = 256, BK = 64, HALF = 128, HTB = HALF * BK * 2, STAGE_BYTES = 8 * HTB, NXCD = 8, WGM = 8;
__host__ __device__ __forceinline__ int lds_byte(int r, int c) { const int st = (r >> 4) * 2 + (c >> 5), rr = r & 15, cc = c & 31, ob = rr * 64 + cc * 2; return st * 1024 + (ob ^ (((ob >> 9) & 1) << 5)); }
__host__ __device__ __forceinline__ void stage_rc(int b, int& R, int& C) { const int st = b / 1024, sb = b % 1024, swz = sb ^ (((sb >> 9) & 1) << 5); R = (st >> 1) * 16 + swz / 64; C = (st & 1) * 32 + (swz % 64) / 2; }
__host__ __device__ __forceinline__ int perm32(int rho) { const int n = rho >> 4, i = rho & 15; return 8 * (i >> 2) + 4 * n + (i & 3); }

struct Unit { int pm, pn, pb; };
struct Gemm { const bf16_t* A; const bf16_t* Bt; int lda, ldb, K; size_t bsA, bsB; };

struct Order {
    int nM, nN, nB, nwg, G, c; bool grouped;
    __device__ void init(int nM_, int nN_, int nB_, int G_, int c_) { nM = nM_; nN = nN_; nB = nB_; nwg = nM * nN * nB; G = G_; c = c_; grouped = nB_ > 1; }
    __device__ bool next(int i, Unit& u) const {
        const long L = (long)i * G + c; if (c < 0 || L >= nwg) return false;
        if (grouped) { const int l = (int)L, per = nM * nN; u.pb = l / per; const int r = l % per; u.pn = r / nM; u.pm = r % nM; return true; }
        int wgid = (int)L; { const int q = nwg / NXCD, r = nwg % NXCD, xcd = wgid % NXCD, off = wgid / NXCD; wgid = (xcd < r ? xcd * (q + 1) : r * (q + 1) + (xcd - r) * q) + off; }
        const int nig = WGM * nN, gid = wgid / nig, fm = gid * WGM, gsz = (nM - fm) < WGM ? (nM - fm) : WGM;
        u.pm = fm + ((wgid % nig) % gsz); u.pn = (wgid % nig) / gsz; u.pb = 0; return true;
    }
};

enum EpMode { EP_SWIGLU = 0, EP_RESID, EP_PROJ, EP_GATES, EP_SLOC, EP_Y, EP_BF16, EP_MERGE };
struct Epi {
    int mode; bool perm;
    const float* ss;
    bf16_t* O;
    bf16_t* O2;
    const float* R; float* out; bf16_t* xb; float* ss_out; float alpha;
    bf16_t *Q, *Kimg, *Vimg, *uext; float* kmp;
    float* sloc;
    const float* dsk;
    const bf16_t *aup, *sga, *sgs;
};
constexpr int RS_OFF = 131072 + 1024, RS_MAXU = 6;
__device__ __forceinline__ u32x4 pack8(const f32x4 a, const f32x4 b) { u32x4 w; w.x = cvtpk(a[0], a[1]); w.y = cvtpk(a[2], a[3]); w.z = cvtpk(b[0], b[1]); w.w = cvtpk(b[2], b[3]); return w; }

__device__ __forceinline__ void epilogue(const Epi& E, const f32x4 (&acc)[2][2][4][2], const Unit& u, int wr, int wc, int fr, int fq, const LAS float* rsl) {
    asm volatile("" : "+v"(fr), "+v"(fq));
    const int rowb = u.pm * BM + wr * 64 + fr;
    if (E.mode == EP_SWIGLU) {
        const int col = u.pn * 128 + wc * 32 + 8 * fq;
#pragma unroll
        for (int ai = 0; ai < 2; ++ai)
#pragma unroll
            for (int m = 0; m < 4; ++m) { const int row = rowb + ai * HALF + m * 16; const float rs = rsl[ai * HALF + wr * 64 + m * 16 + fr];
                f32x4 o[2];
#pragma unroll
                for (int n = 0; n < 2; ++n) { const f32x4 g = acc[ai][0][m][n] * rs, up = acc[ai][1][m][n] * rs;
#pragma unroll
                    for (int j = 0; j < 4; ++j) o[n][j] = g[j] * fast_sigmoid(g[j]) * up[j]; }
                *(u32x4*)(E.O + (size_t)row * DFF + col) = pack8(o[0], o[1]); }
    } else if (E.mode == EP_RESID) {
#pragma unroll
        for (int ai = 0; ai < 2; ++ai) { f32x4 r[4][2][2];
#pragma unroll
            for (int m = 0; m < 4; ++m)
#pragma unroll
                for (int bj = 0; bj < 2; ++bj)
#pragma unroll
                    for (int n = 0; n < 2; ++n) r[m][bj][n] = *(const f32x4*)(E.R + (size_t)(rowb + ai * HALF + m * 16) * DM + u.pn * BM + bj * HALF + wc * 32 + n * 16 + 4 * fq);
#pragma unroll
            for (int m = 0; m < 4; ++m) { const int row = rowb + ai * HALF + m * 16; float sq = 0.f;
#pragma unroll
                for (int bj = 0; bj < 2; ++bj)
#pragma unroll
                    for (int n = 0; n < 2; ++n) { const size_t off = (size_t)row * DM + u.pn * BM + bj * HALF + wc * 32 + n * 16 + 4 * fq;
                        const f32x4 v = r[m][bj][n] + acc[ai][bj][m][n] * E.alpha;
                        *(f32x4*)(E.out + off) = v;
                        if (E.xb) { u32x2 w; w.x = cvtpk(v[0], v[1]); w.y = cvtpk(v[2], v[3]); *(u32x2*)(E.xb + off) = w; }
                        sq += (v[0] * v[0] + v[1] * v[1]) + (v[2] * v[2] + v[3] * v[3]); }
                sq += __shfl_xor(sq, 16); sq += __shfl_xor(sq, 32);
                if (fq == 0) E.ss_out[(size_t)row * 16 + u.pn * 4 + wc] = sq; } }
    } else if (E.mode == EP_PROJ) {
        const int c0t = u.pn * BM + wc * 32 + 8 * fq;
        const int b = u.pm >> 5, blk = u.pm & 31;
        float ksum[2][8];
#pragma unroll
        for (int bj = 0; bj < 2; ++bj)
#pragma unroll
            for (int j = 0; j < 8; ++j) ksum[bj][j] = 0.f;
#pragma unroll
        for (int ai = 0; ai < 2; ++ai)
#pragma unroll
            for (int m = 0; m < 4; ++m) { const int row = rowb + ai * HALF + m * 16; const float rs = rsl[ai * HALF + wr * 64 + m * 16 + fr];
                const int key = row & 255, t = row & (SEQ - 1);
#pragma unroll
                for (int bj = 0; bj < 2; ++bj) { const int c0 = c0t + bj * HALF; const f32x4 v0 = acc[ai][bj][m][0] * rs, v1 = acc[ai][bj][m][1] * rs; const u32x4 w = pack8(v0, v1);
                    if (u.pn < 2) { *(u32x4*)(E.Q + (size_t)row * AW + c0) = w; }
                    else if (u.pn < 4) { const int ck = c0 - 512, h = ck >> 6, d0 = ck & 63;
                        *(u32x4*)(E.Kimg + ((size_t)((b * NH + h) * NBLK + blk)) * (MBLK * HD) + (d0 >> 3) * 2048 + key * 8) = w;
#pragma unroll
                        for (int j = 0; j < 4; ++j) { ksum[bj][j] += v0[j]; ksum[bj][4 + j] += v1[j]; } }
                    else if (u.pn < 6) { const int cv = c0 - 1024, h = cv >> 6, d0 = cv & 63;
                        *(u32x4*)(E.Vimg + ((size_t)((b * NH + h) * NBLK + blk)) * (MBLK * HD) + (d0 >> 5) * 8192 + key * 32 + (d0 & 31)) = w; }
                    else { const int cu = c0 - 1536, g = cu >> 4, hh = cu & 15;
                        *(u32x4*)(E.uext + ((size_t)(g * NCHUNK + (row >> 5))) * UK + (row & 31) * 16 + hh) = w; (void)t; } } }
        if (u.pn >= 2 && u.pn < 4) {
#pragma unroll
            for (int bj = 0; bj < 2; ++bj) { const int ck = c0t + bj * HALF - 512, h = ck >> 6, d0 = ck & 63;
#pragma unroll
                for (int j = 0; j < 8; ++j) { float s = ksum[bj][j]; s += __shfl_xor(s, 1); s += __shfl_xor(s, 2); s += __shfl_xor(s, 4); s += __shfl_xor(s, 8); ksum[bj][j] = s; }
                if (fr == 0) { float* kp = E.kmp + ((size_t)(((b * NH + h) * NBLK + blk) * 2 + wr)) * HD + d0;
                    *(f32x4*)kp = (f32x4){ksum[bj][0], ksum[bj][1], ksum[bj][2], ksum[bj][3]}; *(f32x4*)(kp + 4) = (f32x4){ksum[bj][4], ksum[bj][5], ksum[bj][6], ksum[bj][7]}; } }
        }
    } else if (E.mode == EP_GATES) {
        bf16_t* base = (u.pn < 4) ? E.O : E.O2; const int col = (u.pn & 3) * BM + wc * 32 + 8 * fq;
#pragma unroll
        for (int ai = 0; ai < 2; ++ai)
#pragma unroll
            for (int m = 0; m < 4; ++m) { const int row = rowb + ai * HALF + m * 16; const float rs = rsl[ai * HALF + wr * 64 + m * 16 + fr];
#pragma unroll
                for (int bj = 0; bj < 2; ++bj) { f32x4 o[2];
#pragma unroll
                    for (int n = 0; n < 2; ++n)
#pragma unroll
                        for (int j = 0; j < 4; ++j) o[n][j] = fast_sigmoid(acc[ai][bj][m][n][j] * rs);
                    *(u32x4*)(base + (size_t)row * DM + col + bj * HALF) = pack8(o[0], o[1]); } }
    } else if (E.mode == EP_SLOC) {
#pragma unroll
        for (int ai = 0; ai < 2; ++ai)
#pragma unroll
            for (int m = 0; m < 4; ++m) { const int row = rowb + ai * HALF + m * 16;
#pragma unroll
                for (int n = 0; n < 2; ++n) *(f32x4*)(E.sloc + ((size_t)(u.pb * NCHUNK + row)) * 128 + wc * 32 + n * 16 + 4 * fq) = acc[ai][0][m][n]; }
    } else if (E.mode == EP_Y) {
        const int g = u.pb;
#pragma unroll
        for (int ai = 0; ai < 2; ++ai) { u32x4 uw[4][2];
#pragma unroll
            for (int m = 0; m < 4; ++m)
#pragma unroll
                for (int bj = 0; bj < 2; ++bj) { const int n0 = u.pn * BM + bj * HALF + wc * 32 + 8 * fq; uw[m][bj] = *(const u32x4*)(E.uext + ((size_t)(g * NCHUNK + rowb + ai * HALF + m * 16)) * UK + n0); }
#pragma unroll
            for (int m = 0; m < 4; ++m) { const int chunk = rowb + ai * HALF + m * 16;
#pragma unroll
                for (int bj = 0; bj < 2; ++bj) { const int n0 = u.pn * BM + bj * HALF + wc * 32 + 8 * fq, j = n0 >> 4, c0 = n0 & 15; const u32x4 w = uw[m][bj];
                    const f32x4 d0 = *(const f32x4*)(E.dsk + g * 16 + c0), d1 = *(const f32x4*)(E.dsk + g * 16 + c0 + 4);
                    f32x4 y0 = acc[ai][bj][m][0], y1 = acc[ai][bj][m][1];
                    y0[0] += d0[0] * bf_lo(w.x); y0[1] += d0[1] * bf_hi(w.x); y0[2] += d0[2] * bf_lo(w.y); y0[3] += d0[3] * bf_hi(w.y);
                    y1[0] += d1[0] * bf_lo(w.z); y1[1] += d1[1] * bf_hi(w.z); y1[2] += d1[2] * bf_lo(w.w); y1[3] += d1[3] * bf_hi(w.w);
#pragma unroll
                    for (int q = 0; q < 4; ++q) { y0[q] = gelu_tanh_f(y0[q]); y1[q] = gelu_tanh_f(y1[q]); }
                    *(u32x4*)(E.O + ((size_t)(chunk * SCH + j)) * SW + g * 16 + c0) = pack8(y0, y1); } } }
    } else if (E.mode == EP_BF16) {
#pragma unroll
        for (int ai = 0; ai < 2; ++ai)
#pragma unroll
            for (int m = 0; m < 4; ++m) { const int row = rowb + ai * HALF + m * 16;
#pragma unroll
                for (int bj = 0; bj < 2; ++bj) *(u32x4*)(E.O + (size_t)row * DM + u.pn * BM + bj * HALF + wc * 32 + 8 * fq) = pack8(acc[ai][bj][m][0], acc[ai][bj][m][1]); }
    } else {
        const int col = u.pn * 128 + wc * 32 + 8 * fq;
#pragma unroll
        for (int ai = 0; ai < 2; ++ai) { u32x4 la[4], lga[4], lgs[4];
#pragma unroll
            for (int m = 0; m < 4; ++m) { const size_t off = (size_t)(rowb + ai * HALF + m * 16) * DM + col; la[m] = *(const u32x4*)(E.aup + off); lga[m] = *(const u32x4*)(E.sga + off); lgs[m] = *(const u32x4*)(E.sgs + off); }
#pragma unroll
            for (int m = 0; m < 4; ++m) { const size_t off = (size_t)(rowb + ai * HALF + m * 16) * DM + col; const u32x4 wa = la[m], wga = lga[m], wgs = lgs[m];
                const f32x4 v0 = acc[ai][0][m][0], v1 = acc[ai][0][m][1], t0 = acc[ai][1][m][0], t1 = acc[ai][1][m][1];
                f32x4 o0, o1;
                o0[0] = bf_lo(wga.x) * bf_lo(wa.x) + bf_lo(wgs.x) * (v0[0] * fast_sigmoid(t0[0])); o0[1] = bf_hi(wga.x) * bf_hi(wa.x) + bf_hi(wgs.x) * (v0[1] * fast_sigmoid(t0[1]));
                o0[2] = bf_lo(wga.y) * bf_lo(wa.y) + bf_lo(wgs.y) * (v0[2] * fast_sigmoid(t0[2])); o0[3] = bf_hi(wga.y) * bf_hi(wa.y) + bf_hi(wgs.y) * (v0[3] * fast_sigmoid(t0[3]));
                o1[0] = bf_lo(wga.z) * bf_lo(wa.z) + bf_lo(wgs.z) * (v1[0] * fast_sigmoid(t1[0])); o1[1] = bf_hi(wga.z) * bf_hi(wa.z) + bf_hi(wgs.z) * (v1[1] * fast_sigmoid(t1[1]));
                o1[2] = bf_lo(wga.w) * bf_lo(wa.w) + bf_lo(wgs.w) * (v1[2] * fast_sigmoid(t1[2])); o1[3] = bf_hi(wga.w) * bf_hi(wa.w) + bf_hi(wgs.w) * (v1[3] * fast_sigmoid(t1[3]));
                *(u32x4*)(E.O + off) = pack8(o0, o1); } }
    }
}

template <bool ALIGN_EPI, bool SP2>
__device__ __forceinline__ void gemm_phase(LAS unsigned char* lds, const Gemm g, const Order& S, const Epi& E) {
    int tid = threadIdx.x; asm volatile("" : "+v"(tid));
    const int wid = __builtin_amdgcn_readfirstlane(tid >> 6), lane = tid & 63, wr = wid >> 2, wc = wid & 3, fr = lane & 15, fq = lane >> 4;
    const int K = g.K, nt = K / BK;
    unsigned voffA[2], voffB[2];
#pragma unroll
    for (int i = 0; i < 2; ++i) { int R, C; stage_rc(tid * 16 + i * 8192, R, C); const int Rb = E.perm ? ((R & ~31) + perm32(R & 31)) : R;
        voffA[i] = (unsigned)(R * g.lda + C) * 2u; voffB[i] = (unsigned)(Rb * g.ldb + C) * 2u; }
    const size_t kstep = (size_t)(BK * 2);
    const size_t hstepA = (size_t)HALF * g.lda * 2, hstepB = (size_t)HALF * g.ldb * 2;
    const size_t tstepA = 2 * hstepA, tstepB = 2 * hstepB;
    const unsigned ldsw = (unsigned)wid * 1024u;
    const int aoff = lds_byte(wr * 64 + fr, fq * 8), boff = lds_byte(wc * 32 + fr, fq * 8);
#define PG8_SA(b, h) (((b) * 2 + (h)) * HTB)
#define PG8_SB(b, h) ((4 + (b) * 2 + (h)) * HTB)
#define PG8_STAGE(bufoff, gbase, voff) do { _Pragma("unroll") for (int _i = 0; _i < 2; ++_i) \
        __builtin_amdgcn_global_load_lds((const unsigned*)((const char*)(gbase) + (voff)[_i]), (LAS unsigned*)(lds + (bufoff) + ldsw + _i * 8192), 16, 0, 0); } while (0)
#define PG8_LDA(dst, b, h) do { _Pragma("unroll") for (int m = 0; m < 4; ++m) _Pragma("unroll") for (int k = 0; k < 2; ++k) dst[m][k] = *(const LAS bf16x8*)(lds + PG8_SA(b, h) + aoff + m * 2048 + k * 1024); } while (0)
#define PG8_LDB(dst, b, h) do { _Pragma("unroll") for (int n = 0; n < 2; ++n) _Pragma("unroll") for (int k = 0; k < 2; ++k) dst[n][k] = *(const LAS bf16x8*)(lds + PG8_SB(b, h) + boff + n * 2048 + k * 1024); } while (0)
#define PG8_MMA(ai, bj, At, Bt) do { __builtin_amdgcn_s_setprio(1); _Pragma("unroll") for (int m = 0; m < 4; ++m) _Pragma("unroll") for (int n = 0; n < 2; ++n) _Pragma("unroll") for (int k = 0; k < 2; ++k) \
        acc[ai][bj][m][n] = __builtin_amdgcn_mfma_f32_16x16x32_bf16(Bt[n][k], At[m][k], acc[ai][bj][m][n], 0, 0, 0); __builtin_amdgcn_s_setprio(0); } while (0)
#define PG8_WAIT_V(n) asm volatile("s_waitcnt vmcnt(" #n ")" ::: "memory")
#define PG8_WAIT_L(n) asm volatile("s_waitcnt lgkmcnt(" #n ")" ::: "memory")
#define PG8_BAR __builtin_amdgcn_s_barrier()
#define PG8_SCHED __builtin_amdgcn_sched_barrier(0)
    Unit cur, nxt; int ui = 0;
    if (!S.next(0, cur)) return;
    LAS float* rstab = (LAS float*)(lds + RS_OFF);
    if (E.ss) {
        Unit uu;
        for (int i = tid >> 8; i < RS_MAXU && S.next(i, uu); i += 2) { const int rl = tid & 255; const f32x4* sp = (const f32x4*)(E.ss + (size_t)(uu.pm * BM + rl) * 16);
            const f32x4 a = sp[0], b = sp[1], c = sp[2], d = sp[3]; const float s = ((a[0] + a[1]) + (a[2] + a[3])) + ((b[0] + b[1]) + (b[2] + b[3])) + ((c[0] + c[1]) + (c[2] + c[3])) + ((d[0] + d[1]) + (d[2] + d[3]));
            rstab[i * 256 + rl] = __builtin_amdgcn_rsqf(s * (1.0f / DM) + EPS); }
        __syncthreads();
    }
    f32x4 acc[2][2][4][2];
#pragma unroll
    for (int a = 0; a < 2; ++a)
#pragma unroll
        for (int b = 0; b < 2; ++b)
#pragma unroll
            for (int m = 0; m < 4; ++m)
#pragma unroll
                for (int n = 0; n < 2; ++n) acc[a][b][m][n] = (f32x4){0.f, 0.f, 0.f, 0.f};
    bf16x8 At[4][2], B0[2][2], B1[2][2];
    const char* cA = (const char*)g.A + (size_t)cur.pb * g.bsA + (size_t)cur.pm * tstepA; const char* cB = (const char*)g.Bt + (size_t)cur.pb * g.bsB + (size_t)cur.pn * tstepB;
    if constexpr (SP2) {
        PG8_STAGE(PG8_SB(0, 0), cB, voffB); PG8_STAGE(PG8_SB(0, 1), cB + hstepB, voffB); PG8_STAGE(PG8_SA(0, 0), cA, voffA); PG8_STAGE(PG8_SA(0, 1), cA + hstepA, voffA);
        if (wr == 1) PG8_BAR;
        PG8_WAIT_V(2); PG8_BAR;
        PG8_STAGE(PG8_SB(1, 0), cB + kstep, voffB); PG8_STAGE(PG8_SA(1, 0), cA + kstep, voffA); PG8_STAGE(PG8_SB(1, 1), cB + hstepB + kstep, voffB);
        PG8_WAIT_V(6); PG8_BAR;
    } else {
        PG8_STAGE(PG8_SB(0, 0), cB, voffB); PG8_STAGE(PG8_SA(0, 0), cA, voffA); PG8_STAGE(PG8_SB(0, 1), cB + hstepB, voffB); PG8_STAGE(PG8_SA(0, 1), cA + hstepA, voffA);
        if (wr == 1) PG8_BAR;
        PG8_WAIT_V(4); PG8_BAR;
        PG8_STAGE(PG8_SB(1, 0), cB + kstep, voffB); PG8_STAGE(PG8_SA(1, 0), cA + kstep, voffA); PG8_STAGE(PG8_SB(1, 1), cB + hstepB + kstep, voffB);
        PG8_WAIT_V(6); PG8_BAR;
    }
    for (;;) {
        const bool has_next = S.next(ui + 1, nxt);
        const char* nA = has_next ? (const char*)g.A + (size_t)nxt.pb * g.bsA + (size_t)nxt.pm * tstepA : cA; const char* nB = has_next ? (const char*)g.Bt + (size_t)nxt.pb * g.bsB + (size_t)nxt.pn * tstepB : cB;
        for (int t = 0; t < nt; t += 2) {
            const bool last = (t == nt - 2);
            const char* a1 = cA + (size_t)(t + 1) * kstep;
            const char* a2 = last ? nA : cA + (size_t)(t + 2) * kstep; const char* b2 = last ? nB : cB + (size_t)(t + 2) * kstep;
            const char* a3 = a2 + kstep; const char* b3 = b2 + kstep;
            if constexpr (SP2) {
            PG8_LDB(B0, 0, 0); PG8_LDB(B1, 0, 1); PG8_SCHED; PG8_LDA(At, 0, 0); PG8_STAGE(PG8_SA(1, 1), a1 + hstepA, voffA);
            PG8_WAIT_V(8); PG8_WAIT_L(0); PG8_BAR; PG8_MMA(0, 0, At, B0); PG8_MMA(0, 1, At, B1); PG8_BAR; PG8_SCHED;
            PG8_LDA(At, 0, 1); PG8_STAGE(PG8_SB(0, 0), b2, voffB); PG8_STAGE(PG8_SB(0, 1), b2 + hstepB, voffB); PG8_STAGE(PG8_SA(0, 0), a2, voffA);
            PG8_WAIT_V(8); PG8_WAIT_L(0); PG8_BAR; PG8_MMA(1, 0, At, B0); PG8_MMA(1, 1, At, B1); PG8_BAR; PG8_SCHED;
            PG8_LDB(B0, 1, 0); PG8_LDB(B1, 1, 1); PG8_SCHED; PG8_LDA(At, 1, 0); PG8_STAGE(PG8_SA(0, 1), a2 + hstepA, voffA);
            PG8_WAIT_V(8); PG8_WAIT_L(0); PG8_BAR; PG8_MMA(0, 0, At, B0); PG8_MMA(0, 1, At, B1); PG8_BAR; PG8_SCHED;
            PG8_LDA(At, 1, 1); PG8_STAGE(PG8_SB(1, 0), b3, voffB); PG8_STAGE(PG8_SB(1, 1), b3 + hstepB, voffB); PG8_STAGE(PG8_SA(1, 0), a3, voffA);
            PG8_WAIT_V(8); PG8_WAIT_L(0); PG8_BAR; PG8_MMA(1, 0, At, B0); PG8_MMA(1, 1, At, B1); PG8_BAR; PG8_SCHED;
            } else {
            PG8_LDB(B0, 0, 0); PG8_SCHED; PG8_LDA(At, 0, 0); PG8_STAGE(PG8_SA(1, 1), a1 + hstepA, voffA);
            PG8_WAIT_L(8); PG8_BAR; PG8_WAIT_L(0); PG8_MMA(0, 0, At, B0); PG8_BAR; PG8_SCHED;
            PG8_LDB(B1, 0, 1); PG8_STAGE(PG8_SB(0, 0), b2, voffB);
            PG8_BAR; PG8_WAIT_L(0); PG8_MMA(0, 1, At, B1); PG8_BAR;
            PG8_LDA(At, 0, 1); PG8_STAGE(PG8_SA(0, 0), a2, voffA);
            PG8_BAR; PG8_WAIT_L(0); PG8_MMA(1, 0, At, B0); PG8_BAR; PG8_SCHED;
            PG8_STAGE(PG8_SB(0, 1), b2 + hstepB, voffB);
            PG8_WAIT_V(6); PG8_BAR; PG8_MMA(1, 1, At, B1); PG8_BAR;
            PG8_LDB(B0, 1, 0); PG8_SCHED; PG8_LDA(At, 1, 0); PG8_STAGE(PG8_SA(0, 1), a2 + hstepA, voffA);
            PG8_WAIT_L(8); PG8_BAR; PG8_WAIT_L(0); PG8_MMA(0, 0, At, B0); PG8_BAR; PG8_SCHED;
            PG8_LDB(B1, 1, 1); PG8_STAGE(PG8_SB(1, 0), b3, voffB);
            PG8_BAR; PG8_WAIT_L(0); PG8_MMA(0, 1, At, B1); PG8_BAR;
            PG8_LDA(At, 1, 1); PG8_STAGE(PG8_SA(1, 0), a3, voffA);
            PG8_BAR; PG8_WAIT_L(0); PG8_MMA(1, 0, At, B0); PG8_BAR; PG8_SCHED;
            PG8_STAGE(PG8_SB(1, 1), b3 + hstepB, voffB);
            PG8_WAIT_V(6); PG8_BAR; PG8_MMA(1, 1, At, B1); PG8_BAR;
            }
        }
        if constexpr (ALIGN_EPI) { if (wr == 0) PG8_BAR; }
        epilogue(E, acc, cur, wr, wc, fr, fq, rstab + (ui < RS_MAXU ? ui : 0) * 256);
        if (!has_next) break;
#pragma unroll
        for (int a = 0; a < 2; ++a)
#pragma unroll
            for (int b = 0; b < 2; ++b)
#pragma unroll
                for (int m = 0; m < 4; ++m)
#pragma unroll
                    for (int n = 0; n < 2; ++n) acc[a][b][m][n] = (f32x4){0.f, 0.f, 0.f, 0.f};
        cur = nxt; cA = nA; cB = nB; ++ui;
        if constexpr (ALIGN_EPI) { if (wr == 1) PG8_BAR; }
    }
    PG8_WAIT_V(0);
    if constexpr (!ALIGN_EPI) { if (wr == 0) PG8_BAR; }
    PG8_BAR;
#undef PG8_SA
#undef PG8_SB
#undef PG8_STAGE
#undef PG8_LDA
#undef PG8_LDB
#undef PG8_MMA
#undef PG8_WAIT_V
#undef PG8_WAIT_L
#undef PG8_BAR
#undef PG8_SCHED
}
}
constexpr size_t MiB = 1u << 20;
constexpr size_t WS_CTL = 0, CTL_ZERO_BYTES = 1 * MiB;
constexpr size_t WS_SS = 1 * MiB;
constexpr size_t WS_KMP = 2 * MiB;
constexpr size_t WS_SEL = 2 * MiB + 512 * 1024;
constexpr size_t WS_COEF = 2 * MiB + 256 * 1024;
constexpr size_t WS_KT = 3 * MiB;
constexpr size_t WS_WGU1 = 4 * MiB, WS_WD1 = 15 * MiB, WS_WIN = WS_WD1 + 5 * MiB + 512 * 1024, WS_WAU = WS_WIN + 8 * MiB, WS_WGLU = WS_WAU + 1 * MiB, WS_WOUT = WS_WGLU + 2 * MiB,
                 WS_WGU2 = WS_WOUT + 2 * MiB, WS_WD2 = WS_WGU2 + 11 * MiB;
static_assert(WS_WD2 + 5 * MiB + 512 * 1024 == 50 * MiB, "weights end at 50 MiB");
constexpr size_t WS_TV = 50 * MiB;
constexpr size_t WS_WLOC = 70 * MiB;
constexpr size_t WS_R1 = 78 * MiB;
constexpr size_t WS_ACT = 110 * MiB;
constexpr size_t WS_Q = 110 * MiB, WS_K = 126 * MiB, WS_V = 142 * MiB, WS_UEXT = 158 * MiB, WS_OPART = 178 * MiB, WS_LPART = 226 * MiB, WS_SLOC = 228 * MiB, WS_GY = 236 * MiB;
constexpr size_t WS_AUP = 126 * MiB, WS_SGA = 158 * MiB, WS_SGS = 190 * MiB, WS_X2B = 198 * MiB, WS_END = 256 * MiB;
constexpr int CW_TMO = 0, CW_CODE = 1, CW_BAR = 4096;

constexpr int RING_BYTES = 131072, LDSCTL_OFF = RING_BYTES, MISC_OFF = LDSCTL_OFF + 320, LDS_BYTES = 147456;
constexpr int NWAVES = 8, NTHR = 512;

#define RLX_AGENT __ATOMIC_RELAXED, __HIP_MEMORY_SCOPE_AGENT
#define LDS_WAIT() asm volatile("s_waitcnt lgkmcnt(0)" ::: "memory")
#define VM_WAIT() asm volatile("s_waitcnt vmcnt(0)" ::: "memory")

#define XB_TMO      128
#define XB_XCNT(j)  (256  + 64 * (j))
#define XB_XSUB(j)  (1280 + 64 * (j))
#define XB_XGEN(j)  (2304 + 64 * (j))
#define XB_TOP      3328
#define XB_TOPGEN   3392
#define XCD_BAR_WORDS 3456
#define XB_SPIN_CAP (1u << 18)
__device__ __forceinline__ unsigned xb_ld(unsigned* p)              { return __hip_atomic_load(p, __ATOMIC_RELAXED, __HIP_MEMORY_SCOPE_AGENT); }
__device__ __forceinline__ unsigned xb_add(unsigned* p, unsigned v) { return __hip_atomic_fetch_add(p, v, __ATOMIC_RELAXED, __HIP_MEMORY_SCOPE_AGENT); }
__device__ __forceinline__ unsigned xb_xcc_id() { return (unsigned)__builtin_amdgcn_s_getreg((3 << 11) | 20) & 0xFu; }
#define XB_SPIN(cond, bar) do { unsigned _sp = 0; while (cond) { __builtin_amdgcn_s_sleep(1); \
    if ((++_sp & 255u) == 0u) { if (xb_ld(&(bar)[XB_TMO])) break; if (_sp > XB_SPIN_CAP) { atomicAdd(&(bar)[XB_TMO], 1u); break; } } } } while (0)
struct XcdBarrier { unsigned* bar; unsigned x; volatile LAS unsigned* st; };
__device__ __forceinline__ XcdBarrier xcd_barrier_post(unsigned* bar, volatile LAS unsigned* st) {
    XcdBarrier b; b.bar = bar; b.x = xb_xcc_id(); b.st = st;
    if (threadIdx.x == 0) (void)xb_add(&bar[XB_XCNT(b.x)], 1u);
    return b;
}
__device__ __forceinline__ void xcd_barrier_complete(unsigned* bar, unsigned x, unsigned& nloc, unsigned& nx) {
    const unsigned G = gridDim.x * gridDim.y * gridDim.z;
    unsigned sum, cnt, mine, sp = 0u;
    for (;;) {
        sum = 0u; cnt = 0u; mine = 0u;
#pragma unroll
        for (unsigned j = 0; j < 16; ++j) { const unsigned c = xb_ld(&bar[XB_XCNT(j)]); sum += c; cnt += (c > 0u) ? 1u : 0u; mine = (j == x) ? c : mine; }
        if (sum == G) break;
        __builtin_amdgcn_s_sleep(1);
        if ((++sp & 255u) == 0u) { if (xb_ld(&bar[XB_TMO])) break; if (sp > XB_SPIN_CAP) { atomicAdd(&bar[XB_TMO], 1u); break; } }
    }
    nloc = mine > 0u ? mine : 1u; nx = cnt > 0u ? cnt : 1u;
}
__device__ __forceinline__ void xcd_barrier(const XcdBarrier& b) {
    asm volatile("s_waitcnt vmcnt(0)" ::: "memory");
    __syncthreads();
    if (threadIdx.x == 0) {
        unsigned* bar = b.bar;
        __builtin_amdgcn_s_waitcnt(0);
        unsigned nloc = b.st[0], nx = b.st[1];
        if (nloc == 0u) { xcd_barrier_complete(bar, b.x, nloc, nx); b.st[0] = nloc; b.st[1] = nx; }
        const unsigned old = xb_add(&bar[XB_XSUB(b.x)], 1u);
        const unsigned gen = old / nloc;
        if (old + 1u == (gen + 1u) * nloc) {
            __builtin_amdgcn_fence(__ATOMIC_RELEASE, "agent");
            asm volatile("s_waitcnt vmcnt(0)" ::: "memory");
            const unsigned og = xb_add(&bar[XB_TOP], 1u);
            const unsigned tg = og / nx;
            if (og + 1u == (tg + 1u) * nx) xb_add(&bar[XB_TOPGEN], 1u);
            else XB_SPIN(xb_ld(&bar[XB_TOPGEN]) == tg, bar);
            __builtin_amdgcn_fence(__ATOMIC_ACQUIRE, "agent");
            xb_add(&bar[XB_XGEN(b.x)], 1u);
            asm volatile("s_waitcnt vmcnt(0)" ::: "memory");
        } else {
            XB_SPIN(xb_ld(&bar[XB_XGEN(b.x)]) == gen, bar);
            __builtin_amdgcn_fence(__ATOMIC_ACQUIRE, "agent");
            asm volatile("s_waitcnt vmcnt(0)" ::: "memory");
        }
    }
    __syncthreads();
}

struct Frame {
    LAS unsigned char* lds;
    int vcu, G;
    unsigned char* ws;
    const float* in[23]; float* out;
};
__device__ __forceinline__ int fresh_tid() { int t = threadIdx.x; asm volatile("" : "+v"(t)); return t; }
#define FRESH_IDS const int f_tid = fresh_tid(), f_lane = f_tid & 63, f_wave = __builtin_amdgcn_readfirstlane(f_tid >> 6); (void)f_lane; (void)f_wave
__device__ __forceinline__ float wave_sum(float v) {
#pragma unroll
    for (int o = 1; o < 64; o <<= 1) v += __shfl_xor(v, o);
    return v;
}

__device__ __forceinline__ void p0_transpose_item(const float* W, int ldw, int k0, int n0, bf16_t* WT, int ldt, int dest_row0, const float* gain, float scale, LAS float* scr, int lane) {
    f32x4 v[8];
#pragma unroll
    for (int i = 0; i < 8; ++i) v[i] = *(const GAS f32x4*)(W + (size_t)(k0 + 8 * i + (lane >> 3)) * ldw + n0 + (lane & 7) * 4);
#pragma unroll
    for (int i = 0; i < 8; ++i) { const int kk = 8 * i + (lane >> 3); const float gsc = (gain ? gain[k0 + kk] : 1.f) * scale; LAS float* d = scr + kk * 33 + (lane & 7) * 4;
        d[0] = v[i][0] * gsc; d[1] = v[i][1] * gsc; d[2] = v[i][2] * gsc; d[3] = v[i][3] * gsc; }
    LDS_WAIT(); asm volatile("" ::: "memory");
    const int c = lane & 7;
#pragma unroll
    for (int j = 0; j < 4; ++j) { const int n = (lane >> 3) + 8 * j; const LAS float* s = scr + (8 * c) * 33 + n;
        u32x4 o; o.x = cvtpk(s[0 * 33], s[1 * 33]); o.y = cvtpk(s[2 * 33], s[3 * 33]); o.z = cvtpk(s[4 * 33], s[5 * 33]); o.w = cvtpk(s[6 * 33], s[7 * 33]);
        *(GAS u32x4*)(WT + (size_t)(dest_row0 + n) * ldt + k0 + 8 * c) = o; }
    LDS_WAIT(); asm volatile("" ::: "memory");
}
__device__ __forceinline__ int il_lo(int n) { return 256 * (n >> 7) + (n & 127); }

__device__ __forceinline__ double dexp_(double x) {
    const double n = __builtin_rint(x * 1.4426950408889634074), f = __builtin_fma(n, -0.693147180369123816490, x) + n * -1.90821492927058770002e-10;
    double p = 1.0 / 6227020800.0;
    p = p * f + 1.0 / 479001600.0; p = p * f + 1.0 / 39916800.0; p = p * f + 1.0 / 3628800.0; p = p * f + 1.0 / 362880.0; p = p * f + 1.0 / 40320.0; p = p * f + 1.0 / 5040.0;
    p = p * f + 1.0 / 720.0; p = p * f + 1.0 / 120.0; p = p * f + 1.0 / 24.0; p = p * f + 1.0 / 6.0; p = p * f + 0.5; p = p * f + 1.0; p = p * f + 1.0;
    const long long e = (long long)(1023 + (int)n) << 52; return p * __builtin_bit_cast(double, e);
}
__device__ __forceinline__ void dsincos_(double a, double& sn, double& cs) {
    const double rev = a * 0.15915494309189533577; const double r = rev - __builtin_rint(rev);
    const double q = __builtin_rint(4.0 * r), x = (r - 0.25 * q) * 6.28318530717958647692, x2 = x * x;
    double ps = -1.0 / 1307674368000.0; ps = ps * x2 + 1.0 / 6227020800.0; ps = ps * x2 - 1.0 / 39916800.0; ps = ps * x2 + 1.0 / 362880.0; ps = ps * x2 - 1.0 / 5040.0; ps = ps * x2 + 1.0 / 120.0; ps = ps * x2 - 1.0 / 6.0; ps = ps * x2 + 1.0; ps *= x;
    double pc = 1.0 / 20922789888000.0; pc = pc * x2 - 1.0 / 87178291200.0; pc = pc * x2 + 1.0 / 479001600.0; pc = pc * x2 - 1.0 / 3628800.0; pc = pc * x2 + 1.0 / 40320.0; pc = pc * x2 - 1.0 / 720.0; pc = pc * x2 + 1.0 / 24.0; pc = pc * x2 - 0.5; pc = pc * x2 + 1.0;
    const int qi = (int)q & 3;
    sn = (qi == 0) ? ps : (qi == 1) ? pc : (qi == 2) ? -ps : -pc;
    cs = (qi == 0) ? pc : (qi == 1) ? -ps : (qi == 2) ? -pc : ps;
}
__device__ __forceinline__ void ssm_prep_item(Frame& F, int g, int part) {
    FRESH_IDS;
    LAS float* Pr = (LAS float*)F.lds;
    LAS float* Pi = Pr + 33 * 64;
    LAS float* Br = Pi + 33 * 64;
    LAS float* Bi = Br + 1024;
    LAS float* Cr = Bi + 1024;
    LAS float* Ci = Cr + 1024;
    const float *lre = F.in[8], *lim = F.in[9], *ldt = F.in[10], *bre = F.in[11], *bim = F.in[12], *cre = F.in[13], *cim = F.in[14];
    const int tid = f_tid;
    const double dt = dexp_((double)ldt[g]);
    { const int p = tid & 63, dd = tid >> 6; const double lr = lre[g * 64 + p], li = lim[g * 64 + p];
        for (int d = dd; d <= 32; d += 8) { const double mg = dexp_(lr * dt * d); double sn, cs; dsincos_(li * dt * d, sn, cs); Pr[d * 64 + p] = (float)(mg * cs); Pi[d * 64 + p] = (float)(mg * sn); }
        if (dd == 1 && part == 0) { float* co = (float*)(F.ws + WS_COEF) + (g * 64 + p) * 4; const double m32 = dexp_(lr * dt * 32.0), m512 = dexp_(lr * dt * 512.0); double s32, c32, s512, c512; dsincos_(li * dt * 32.0, s32, c32); dsincos_(li * dt * 512.0, s512, c512);
            co[0] = (float)(m32 * c32); co[1] = (float)(m32 * s32); co[2] = (float)(m512 * c512); co[3] = (float)(m512 * s512); } }
#pragma unroll
    for (int e = 0; e < 2; ++e) { const int idx = tid * 2 + e, p = idx >> 4, h = idx & 15; const double lr = lre[g * 64 + p], li = lim[g * 64 + p];
        const double mg = dexp_(lr * dt); double s1, c1; dsincos_(li * dt, s1, c1); const double ar = mg * c1, ai = mg * s1, nr = ar - 1.0, ni = ai, den = lr * lr + li * li;
        const double fr = (nr * lr + ni * li) / den, fi = (ni * lr - nr * li) / den; const double br = bre[(g * 64 + p) * 16 + h], bi = bim[(g * 64 + p) * 16 + h];
        Br[p * 16 + h] = (float)(fr * br - fi * bi); Bi[p * 16 + h] = (float)(fr * bi + fi * br);
        const int c = idx >> 6, pc = idx & 63; Cr[c * 64 + pc] = cre[(g * 16 + c) * 64 + pc]; Ci[c * 64 + pc] = cim[(g * 16 + c) * 64 + pc]; }
    __syncthreads();
    {
        const int d = 4 * part + (tid >> 7), c = (tid >> 3) & 15, h0 = (tid & 7) * 2; float s0 = 0.f, s1 = 0.f;
        for (int p = 0; p < 64; ++p) { const float cr = Cr[c * 64 + p], ci = Ci[c * 64 + p], pr = Pr[d * 64 + p], pi = Pi[d * 64 + p]; const float xr = cr * pr - ci * pi, xi = cr * pi + ci * pr;
            s0 += xr * Br[p * 16 + h0] - xi * Bi[p * 16 + h0]; s1 += xr * Br[p * 16 + h0 + 1] - xi * Bi[p * 16 + h0 + 1]; }
        float* kt = (float*)(F.ws + WS_KT) + (size_t)g * 8192 + d * 256 + c * 16 + h0; *(f32x2*)kt = (f32x2){s0, s1};
    }
    bf16_t* TV = (bf16_t*)(F.ws + WS_TV) + (size_t)g * 512 * UK;
#pragma unroll
    for (int it = 0; it < 2; ++it) { const int id = tid + 512 * it, row = 64 * part + (id >> 4), q = 64 + (id & 15), j = row >> 4, c = row & 15; float v[8];
        const int p0 = ((q - 64) & 7) * 8; const bool im = q >= 72;
#pragma unroll
        for (int e = 0; e < 8; ++e) { const int p = p0 + e; const float cr = Cr[c * 64 + p], ci = Ci[c * 64 + p], pr = Pr[(j + 1) * 64 + p], pi = Pi[(j + 1) * 64 + p];
            v[e] = im ? -(cr * pi + ci * pr) : (cr * pr - ci * pi); }
        u32x4 o; o.x = cvtpk(v[0], v[1]); o.y = cvtpk(v[2], v[3]); o.z = cvtpk(v[4], v[5]); o.w = cvtpk(v[6], v[7]);
        *(GAS u32x4*)(TV + (size_t)row * UK + q * 8) = o; }
    bf16_t* WL = (bf16_t*)(F.ws + WS_WLOC) + (size_t)g * 256 * 512;
#pragma unroll
    for (int it = 0; it < 4; ++it) { const int id = tid + 512 * it, rr = id >> 6, q = id & 63; const int row = (rr < 16) ? 16 * part + rr : 128 + 16 * part + (rr - 16); float v[8];
        if (row < 128) { const int ri = row >> 6, p = row & 63, i = q >> 1, h0 = (q & 1) * 8; const float pr = Pr[(31 - i) * 64 + p], pi = Pi[(31 - i) * 64 + p];
#pragma unroll
            for (int e = 0; e < 8; ++e) { const float br = Br[p * 16 + h0 + e], bi = Bi[p * 16 + h0 + e]; v[e] = ri ? (pr * bi + pi * br) : (pr * br - pi * bi); } }
        else {
#pragma unroll
            for (int e = 0; e < 8; ++e) v[e] = 0.f; }
        u32x4 o; o.x = cvtpk(v[0], v[1]); o.y = cvtpk(v[2], v[3]); o.z = cvtpk(v[4], v[5]); o.w = cvtpk(v[6], v[7]);
        *(GAS u32x4*)(WL + (size_t)row * 512 + q * 8) = o; }
    __syncthreads();
}
__device__ __forceinline__ void tv_expand_item(Frame& F, int g, int part) {
    FRESH_IDS;
    LAS float* Kt = (LAS float*)F.lds;
    const float* kt = (const float*)(F.ws + WS_KT) + (size_t)g * 8192;
    __syncthreads();
#pragma unroll
    for (int i = 0; i < 4; ++i) *(LAS f32x4*)(Kt + (i * 512 + f_tid) * 4) = *(const f32x4*)(kt + (i * 512 + f_tid) * 4);
    __syncthreads();
    bf16_t* TV = (bf16_t*)(F.ws + WS_TV) + (size_t)g * 512 * UK;
#pragma unroll
    for (int it = 0; it < 8; ++it) { const int id = f_tid + 512 * it, row = 64 * part + (id >> 6), q = id & 63, j = row >> 4, c = row & 15, i = q >> 1, h0 = (q & 1) * 8; float v[8];
#pragma unroll
        for (int e = 0; e < 8; ++e) v[e] = (j >= i) ? Kt[(j - i) * 256 + c * 16 + h0 + e] : 0.f;
        u32x4 o; o.x = cvtpk(v[0], v[1]); o.y = cvtpk(v[2], v[3]); o.z = cvtpk(v[4], v[5]); o.w = cvtpk(v[6], v[7]);
        *(GAS u32x4*)(TV + (size_t)row * UK + q * 8) = o; }
    __syncthreads();
}

__device__ __forceinline__ void p0_prologue(Frame& F) {
    FRESH_IDS;
    for (int it = F.vcu; it < 256; it += F.G) ssm_prep_item(F, it >> 3, it & 7);
    LAS float* scr = (LAS float*)(F.lds + f_wave * 16384);
    const int gw = F.vcu * NWAVES + f_wave, NGW = F.G * NWAVES;
    constexpr int I_GU = 16 * 88, I_D = 44 * 32, I_IN = 16 * 128, I_AU = 8 * 32, I_GLU = 8 * 64, I_OUT = 16 * 32;
    constexpr int NITEMS = 4 * I_GU + 2 * I_D + I_IN + I_AU + I_GLU + I_OUT;
    unsigned char* ws = F.ws;
    for (int it = gw; it < NITEMS; it += NGW) {
        int r = it;
        if (r < 4 * I_GU) { const int which = r / I_GU; r -= which * I_GU; const int kb = r / 88, nb = r % 88;
            const float* W = which == 0 ? F.in[2] : which == 1 ? F.in[3] : which == 2 ? F.in[19] : F.in[20]; const float* gain = which < 2 ? F.in[1] : F.in[18];
            bf16_t* WT = (bf16_t*)(ws + (which < 2 ? WS_WGU1 : WS_WGU2));
            p0_transpose_item(W, DFF, 64 * kb, 32 * nb, WT, DM, il_lo(32 * nb) + ((which & 1) ? 128 : 0), gain, 1.f, scr, f_lane); continue; }
        r -= 4 * I_GU;
        if (r < 2 * I_D) { const int which = r / I_D; r -= which * I_D; const int kb = r / 32, nb = r % 32;
            p0_transpose_item(which ? F.in[21] : F.in[4], DM, 64 * kb, 32 * nb, (bf16_t*)(ws + (which ? WS_WD2 : WS_WD1)), DFF, 32 * nb, nullptr, 1.f, scr, f_lane); continue; }
        r -= 2 * I_D;
        if (r < I_IN) { const int kb = r / 128, nb = r % 128;
            p0_transpose_item(F.in[6], INW, 64 * kb, 32 * nb, (bf16_t*)(ws + WS_WIN), DM, 32 * nb, F.in[5], (32 * nb < AW) ? QSCALE : 1.f, scr, f_lane); continue; }
        r -= I_IN;
        if (r < I_AU) { const int kb = r / 32, nb = r % 32;
            p0_transpose_item(F.in[7], DM, 64 * kb, 32 * nb, (bf16_t*)(ws + WS_WAU), AW, 32 * nb, nullptr, 1.f, scr, f_lane); continue; }
        r -= I_AU;
        if (r < I_GLU) { const int kb = r / 64, nb = r % 64; const int n0 = 32 * nb;
            p0_transpose_item(F.in[16], 2048, 64 * kb, n0, (bf16_t*)(ws + WS_WGLU), SW, n0 < 1024 ? il_lo(n0) : il_lo(n0 - 1024) + 128, nullptr, 1.f, scr, f_lane); continue; }
        r -= I_GLU;
        { const int kb = r / 32, nb = r % 32;
            p0_transpose_item(F.in[17], DM, 64 * kb, 32 * nb, (bf16_t*)(ws + WS_WOUT), DM, 32 * nb, nullptr, 1.f, scr, f_lane); }
    }
    bf16_t* XB = (bf16_t*)(ws + WS_R1); float* SS = (float*)(ws + WS_SS);
    for (int m = gw; m < M; m += 2 * NGW) {
        const int m2 = m + NGW;
        const GAS f32x4* xr = (const GAS f32x4*)(F.in[0] + (size_t)m * DM) + f_lane; const GAS f32x4* xr2 = (const GAS f32x4*)(F.in[0] + (size_t)m2 * DM) + f_lane; f32x4 v[4], w[4]; float s = 0.f, s2 = 0.f;
#pragma unroll
        for (int j = 0; j < 4; ++j) { v[j] = xr[64 * j]; w[j] = xr2[64 * j]; }
#pragma unroll
        for (int j = 0; j < 4; ++j) { s += (v[j][0] * v[j][0] + v[j][1] * v[j][1]) + (v[j][2] * v[j][2] + v[j][3] * v[j][3]); s2 += (w[j][0] * w[j][0] + w[j][1] * w[j][1]) + (w[j][2] * w[j][2] + w[j][3] * w[j][3]); }
        s = wave_sum(s); s2 = wave_sum(s2);
        GAS u32x2* o8 = (GAS u32x2*)(XB + (size_t)m * DM) + f_lane; GAS u32x2* o82 = (GAS u32x2*)(XB + (size_t)m2 * DM) + f_lane;
#pragma unroll
        for (int j = 0; j < 4; ++j) { u32x2 a; a.x = cvtpk(v[j][0], v[j][1]); a.y = cvtpk(v[j][2], v[j][3]); o8[64 * j] = a; u32x2 b; b.x = cvtpk(w[j][0], w[j][1]); b.y = cvtpk(w[j][2], w[j][3]); o82[64 * j] = b; }
        if (f_lane < 16) { SS[(size_t)m * 16 + f_lane] = (f_lane == 0) ? s : 0.f; SS[(size_t)m2 * 16 + f_lane] = (f_lane == 0) ? s2 : 0.f; }
    }
}

__device__ __forceinline__ int crow(int r, int hi) { return (r & 3) + 8 * (r >> 2) + 4 * hi; }
constexpr int AL_K = 0, AL_V = 32768, AL_LIST = 65536  , AL_CNT = 81920, AL_WSF = 82432, AL_OST = 84480, AL_END = AL_OST + 8 * 4096;
static_assert(AL_END <= RING_BYTES, "attention LDS");
constexpr int A2_NR = 6;
__device__ __constant__ int A2_LO[A2_NR] = {1, 3, 5, 8, 13, 20}, A2_HI[A2_NR] = {2, 4, 7, 12, 19, 31}, A2_PRE[A2_NR + 1] = {0, 2, 6, 13, 25, 44, 75};
constexpr int A2_ITEMS = 75 * 16;

template <bool OWN>
__device__ __forceinline__ void attn_tile(LAS const unsigned char* KI, LAS const unsigned char* VI, const bf16_t* qrow, float bq, float slope2, int w, int lane, f32x16 (&o)[2], float& m_out, float& l_out) {
    const int r32 = lane & 31, hi = lane >> 5;
    bf16x8 qr[4];
#pragma unroll
    for (int d0 = 0; d0 < 4; ++d0) qr[d0] = *(const bf16x8*)(qrow + 16 * d0 + 8 * hi);
    f32x16 s[8];
    LAS const unsigned char* kp = KI + hi * 4096 + r32 * 16;
#pragma unroll
    for (int kt = 0; kt < 8; ++kt) {
        if (OWN && kt > w) {
#pragma unroll
            for (int r = 0; r < 16; ++r) s[kt][r] = -INFINITY;
        } else {
            const float b0 = bq + slope2 * (32.f * kt); f32x16 acc;
#pragma unroll
            for (int r = 0; r < 16; ++r) acc[r] = b0 + slope2 * (float)((r & 3) + 8 * (r >> 2)) + slope2 * 4.f * (float)hi;
#pragma unroll
            for (int d0 = 0; d0 < 4; ++d0) { const bf16x8 kf = *(LAS const bf16x8*)(kp + d0 * 8192 + kt * 512); acc = __builtin_amdgcn_mfma_f32_32x32x16_bf16(kf, qr[d0], acc, 0, 0, 0); }
            if (OWN && kt == w) {
#pragma unroll
                for (int r = 0; r < 16; ++r) if (crow(r, hi) > r32) acc[r] = -INFINITY;
            }
            s[kt] = acc;
        }
    }
    float m = s[0][0];
#pragma unroll
    for (int kt = 0; kt < 8; ++kt)
#pragma unroll
        for (int r = 0; r < 16; ++r) m = fmaxf(m, s[kt][r]);
    m = fmaxf(m, __shfl_xor(m, 32));
    float l = 0.f;
    u32x4 pw[8][2];
#pragma unroll
    for (int kt = 0; kt < 8; ++kt) {
        if (OWN && kt > w) { pw[kt][0] = (u32x4){0u, 0u, 0u, 0u}; pw[kt][1] = (u32x4){0u, 0u, 0u, 0u}; continue; }
        float p[16];
#pragma unroll
        for (int r = 0; r < 16; ++r) { p[r] = __builtin_amdgcn_exp2f(s[kt][r] - m); l += p[r]; }
#pragma unroll
        for (int s2 = 0; s2 < 2; ++s2) { pw[kt][s2].x = cvtpk(p[8 * s2 + 0], p[8 * s2 + 1]); pw[kt][s2].y = cvtpk(p[8 * s2 + 2], p[8 * s2 + 3]); pw[kt][s2].z = cvtpk(p[8 * s2 + 4], p[8 * s2 + 5]); pw[kt][s2].w = cvtpk(p[8 * s2 + 6], p[8 * s2 + 7]); }
        asm volatile("" : "+v"(pw[kt][0]), "+v"(pw[kt][1]));
    }
    l += __shfl_xor(l, 32);
    m_out = m; l_out = l;
    o[0] = f32x16{}; o[1] = f32x16{};
    LAS const unsigned char* vb = VI + ((lane >> 4) & 1) * 32 + (lane & 3) * 8 + (4 * hi + ((lane & 15) >> 2)) * 64;
#pragma unroll
    for (int kt = 0; kt < 8; ++kt) {
        if (OWN && kt > w) continue;
#pragma unroll
        for (int s2 = 0; s2 < 2; ++s2) {
            const bf16x8 pa = __builtin_bit_cast(bf16x8, pw[kt][s2]);
#pragma unroll
            for (int d0 = 0; d0 < 2; ++d0) {
                LAS const unsigned char* vp = vb + d0 * 16384 + (32 * kt + 16 * s2) * 64;
                const v4i16_t lo = __builtin_amdgcn_ds_read_tr16_b64_v4i16((LAS v4i16_t*)vp), hi4 = __builtin_amdgcn_ds_read_tr16_b64_v4i16((LAS v4i16_t*)(vp + 512));
                const bf16x8 vf = {lo[0], lo[1], lo[2], lo[3], hi4[0], hi4[1], hi4[2], hi4[3]};
                o[d0] = __builtin_amdgcn_mfma_f32_32x32x16_bf16(pa, vf, o[d0], 0, 0, 0);
            }
        }
    }
}
__device__ __forceinline__ void attn_stage(const f32x16 (&o)[2], float l, LAS float* wsf, LAS bf16_t* stg, int lane) {
    const int r32 = lane & 31, hi = lane >> 5;
    if (hi == 0) wsf[r32] = l;
#pragma unroll
    for (int r = 0; r < 16; ++r) { const int qr_ = crow(r, hi); const float rl = __builtin_amdgcn_rcpf(wsf[qr_]);
#pragma unroll
        for (int d0 = 0; d0 < 2; ++d0) { const unsigned w = cvtpk(o[d0][r] * rl, 0.f); stg[qr_ * 64 + d0 * 32 + r32] = (bf16_t)(w & 0xffffu); } }
}
__device__ __forceinline__ void load_kv_images(Frame& F, int f_tid, int f_wave, const bf16_t* kimg, const bf16_t* vimg) {
#pragma unroll
    for (int i = 0; i < 4; ++i) {
        __builtin_amdgcn_global_load_lds((const unsigned*)((const char*)kimg + (size_t)(i * 512 + f_tid) * 16), (LAS unsigned*)(F.lds + AL_K + (i * 512 + f_wave * 64) * 16), 16, 0, 0);
        __builtin_amdgcn_global_load_lds((const unsigned*)((const char*)vimg + (size_t)(i * 512 + f_tid) * 16), (LAS unsigned*)(F.lds + AL_V + (i * 512 + f_wave * 64) * 16), 16, 0, 0);
    }
}

__device__ __forceinline__ void a1_topk(Frame& F) {
    FRESH_IDS;
    LAS float* km = (LAS float*)F.lds;
    const float* KMP = (const float*)(F.ws + WS_KMP); const bf16_t* Q = (const bf16_t*)(F.ws + WS_Q); unsigned* SEL = (unsigned*)(F.ws + WS_SEL);
    for (int it = F.vcu; it < 256; it += F.G) {
        const int bh = it >> 4, seg = it & 15, b = bh >> 3, h = bh & 7;
        __syncthreads();
        for (int e = f_tid; e < 2048; e += NTHR) { const int n = e >> 6, d = e & 63; km[e] = (KMP[((size_t)(bh * NBLK + n) * 2 + 0) * HD + d] + KMP[((size_t)(bh * NBLK + n) * 2 + 1) * HD + d]) * (1.0f / MBLK); }
        __syncthreads();
        const int t = seg * 512 + f_tid, blk = t >> 8;
        const u32x4* qp = (const u32x4*)(Q + ((size_t)(b * SEQ + t)) * AW + h * HD);
        float q[64];
#pragma unroll
        for (int i = 0; i < 8; ++i) { const u32x4 w = qp[i]; q[8 * i + 0] = bf_lo(w.x); q[8 * i + 1] = bf_hi(w.x); q[8 * i + 2] = bf_lo(w.y); q[8 * i + 3] = bf_hi(w.y); q[8 * i + 4] = bf_lo(w.z); q[8 * i + 5] = bf_hi(w.z); q[8 * i + 6] = bf_lo(w.w); q[8 * i + 7] = bf_hi(w.w); }
        float v0 = -INFINITY, v1 = -INFINITY, v2 = -INFINITY; unsigned i0 = 255u, i1 = 255u, i2 = 255u;
        for (int n = 0; n < blk; ++n) { float g = 0.f;
#pragma unroll
            for (int d4 = 0; d4 < 16; ++d4) { const f32x4 kk = *(LAS const f32x4*)(km + n * 64 + d4 * 4); g = fmaf(q[4 * d4], kk[0], g); g = fmaf(q[4 * d4 + 1], kk[1], g); g = fmaf(q[4 * d4 + 2], kk[2], g); g = fmaf(q[4 * d4 + 3], kk[3], g); }
            if (g > v0) { v2 = v1; i2 = i1; v1 = v0; i1 = i0; v0 = g; i0 = (unsigned)n; }
            else if (g > v1) { v2 = v1; i2 = i1; v1 = g; i1 = (unsigned)n; }
            else if (g > v2) { v2 = g; i2 = (unsigned)n; } }
        SEL[(size_t)bh * SEQ + t] = i0 | (i1 << 8) | (i2 << 16);
    }
    __syncthreads();
}

__device__ __forceinline__ void a2_gathered(Frame& F, int first_item_delay) {
    FRESH_IDS;
    const bf16_t* Q = (const bf16_t*)(F.ws + WS_Q); const bf16_t* KI = (const bf16_t*)(F.ws + WS_K); const bf16_t* VI = (const bf16_t*)(F.ws + WS_V);
    const unsigned* SEL = (const unsigned*)(F.ws + WS_SEL); bf16_t* OP = (bf16_t*)(F.ws + WS_OPART); float* LP = (float*)(F.ws + WS_LPART);
    LAS unsigned* list = (LAS unsigned*)(F.lds + AL_LIST); LAS unsigned* cntp = (LAS unsigned*)(F.lds + AL_CNT);
    LAS float* wsf = (LAS float*)(F.lds + AL_WSF) + f_wave * 64; LAS bf16_t* stg = (LAS bf16_t*)(F.lds + AL_OST + f_wave * 4096);
    const int lane = f_lane, r32 = lane & 31, hi = lane >> 5;
    (void)first_item_delay;
    for (int it = F.vcu; it < A2_ITEMS; it += F.G) {
        const int bh = it & 15, j = it >> 4; int rg = 0;
#pragma unroll
        for (int k = 1; k < A2_NR; ++k) if (j >= A2_PRE[k]) rg = k;
        const int n = j - A2_PRE[rg], qb_lo = (A2_LO[rg] > n + 1) ? A2_LO[rg] : n + 1, qb_hi = A2_HI[rg];
        const int b = bh >> 3, h = bh & 7; const float slope2 = exp2f(-(float)(h + 1)) * LOG2E;
        if (f_tid == 0) cntp[0] = 0u;
        load_kv_images(F, f_tid, f_wave, KI + (size_t)(bh * NBLK + n) * (MBLK * HD), VI + (size_t)(bh * NBLK + n) * (MBLK * HD));
        __syncthreads();
        for (int t0 = qb_lo * MBLK; t0 < (qb_hi + 1) * MBLK; t0 += NTHR) {
            const int t = t0 + f_tid; int rank = -1;
            if (t < (qb_hi + 1) * MBLK) { const unsigned wv = SEL[(size_t)bh * SEQ + t]; rank = ((wv & 255u) == (unsigned)n) ? 0 : (((wv >> 8) & 255u) == (unsigned)n) ? 1 : (((wv >> 16) & 255u) == (unsigned)n) ? 2 : -1; }
            const unsigned long long bal = __ballot(rank >= 0);
            unsigned base = 0u;
            if (lane == 0 && bal) base = __hip_atomic_fetch_add(cntp, (unsigned)__popcll(bal), __ATOMIC_RELAXED, __HIP_MEMORY_SCOPE_WORKGROUP);
            base = (unsigned)__builtin_amdgcn_readfirstlane((int)base);
            if (rank >= 0) list[base + (unsigned)__popcll(bal & ((1ull << lane) - 1ull))] = (unsigned)t | ((unsigned)rank << 16);
        }
        VM_WAIT();
        __syncthreads();
        const int cnt = (int)cntp[0];
        LAS const unsigned char* KL = F.lds + AL_K; LAS const unsigned char* VL = F.lds + AL_V;
        for (int tile = f_wave; tile * 32 < cnt; tile += NWAVES) {
            const int idx = tile * 32 + r32; const unsigned e = list[idx < cnt ? idx : 0]; const int t = (int)(e & 0xffffu);
            f32x16 o[2]; float m, l;
            attn_tile<false>(KL, VL, Q + ((size_t)(b * SEQ + t)) * AW + h * HD, slope2 * (float)(n * MBLK - t), slope2, 0, lane, o, m, l);
            attn_stage(o, l, wsf, stg, lane);
            if (hi == 0 && idx < cnt) LP[((size_t)bh * SEQ + t) * 4 + (e >> 16)] = m + __builtin_amdgcn_logf(l);
#pragma unroll
            for (int i = 0; i < 4; ++i) { const int row = i * 8 + (lane >> 3), ch = lane & 7, id2 = tile * 32 + row;
                if (id2 < cnt) { const unsigned e2 = list[id2]; const u32x4 v = *(LAS const u32x4*)(stg + row * 64 + ch * 8);
                    *(u32x4*)(OP + (((size_t)bh * SEQ + (e2 & 0xffffu)) * 3 + (e2 >> 16)) * HD + ch * 8) = v; } }
        }
        __syncthreads();
    }
}

__device__ __forceinline__ void a3_own_item(Frame& F, int it, bool do_store) {
    FRESH_IDS;
    bf16_t* Q = (bf16_t*)(F.ws + WS_Q); const bf16_t* KI = (const bf16_t*)(F.ws + WS_K); const bf16_t* VI = (const bf16_t*)(F.ws + WS_V);
    const bf16_t* OP = (const bf16_t*)(F.ws + WS_OPART); const float* LP = (const float*)(F.ws + WS_LPART);
    LAS float* wsf = (LAS float*)(F.lds + AL_WSF) + f_wave * 64; LAS bf16_t* stg = (LAS bf16_t*)(F.lds + AL_OST + f_wave * 4096);
    const int lane = f_lane, r32 = lane & 31, hi = lane >> 5, w = f_wave;
    const int bh = it >> 5, qb = it & 31, b = bh >> 3, h = bh & 7; const float slope2 = exp2f(-(float)(h + 1)) * LOG2E;
    load_kv_images(F, f_tid, f_wave, KI + (size_t)(bh * NBLK + qb) * (MBLK * HD), VI + (size_t)(bh * NBLK + qb) * (MBLK * HD));
    VM_WAIT();
    __syncthreads();
    const int t = qb * MBLK + w * 32 + r32;
    f32x16 o[2]; float m, l;
    attn_tile<true>(F.lds + AL_K, F.lds + AL_V, Q + ((size_t)(b * SEQ + t)) * AW + h * HD, slope2 * (float)(qb * MBLK - t), slope2, w, lane, o, m, l);
    attn_stage(o, l, wsf, stg, lane);
    if (hi == 0) wsf[32 + r32] = m + __builtin_amdgcn_logf(l);
    const int nv = qb < 3 ? qb : 3;
#pragma unroll
    for (int i = 0; i < 4; ++i) { const int row = i * 8 + (lane >> 3), ch = lane & 7, t2 = qb * MBLK + w * 32 + row;
        const u32x4 ow = *(LAS const u32x4*)(stg + row * 64 + ch * 8); const float lo = wsf[32 + row];
        float ls[3]; float mx = lo;
#pragma unroll
        for (int k = 0; k < 3; ++k) { ls[k] = (k < nv) ? LP[((size_t)bh * SEQ + t2) * 4 + k] : -INFINITY; mx = fmaxf(mx, ls[k]); }
        float wo = __builtin_amdgcn_exp2f(lo - mx), den = wo; float acc[8] = {bf_lo(ow.x) * wo, bf_hi(ow.x) * wo, bf_lo(ow.y) * wo, bf_hi(ow.y) * wo, bf_lo(ow.z) * wo, bf_hi(ow.z) * wo, bf_lo(ow.w) * wo, bf_hi(ow.w) * wo};
#pragma unroll
        for (int k = 0; k < 3; ++k) if (k < nv) { const float wk = __builtin_amdgcn_exp2f(ls[k] - mx); den += wk; const u32x4 pw = *(const u32x4*)(OP + (((size_t)bh * SEQ + t2) * 3 + k) * HD + ch * 8);
            acc[0] += wk * bf_lo(pw.x); acc[1] += wk * bf_hi(pw.x); acc[2] += wk * bf_lo(pw.y); acc[3] += wk * bf_hi(pw.y); acc[4] += wk * bf_lo(pw.z); acc[5] += wk * bf_hi(pw.z); acc[6] += wk * bf_lo(pw.w); acc[7] += wk * bf_hi(pw.w); }
        const float rd = 1.0f / den; u32x4 ov; ov.x = cvtpk(acc[0] * rd, acc[1] * rd); ov.y = cvtpk(acc[2] * rd, acc[3] * rd); ov.z = cvtpk(acc[4] * rd, acc[5] * rd); ov.w = cvtpk(acc[6] * rd, acc[7] * rd);
        if (do_store) *(u32x4*)(Q + ((size_t)(b * SEQ + t2)) * AW + h * HD + ch * 8) = ov; }
    __syncthreads();
}

__device__ __forceinline__ void scan_item(Frame& F, int it) {
    FRESH_IDS;
    LAS float* Er = (LAS float*)F.lds; LAS float* Ei = Er + 512;
    const float* SL = (const float*)(F.ws + WS_SLOC); const float* CO = (const float*)(F.ws + WS_COEF); bf16_t* UX = (bf16_t*)(F.ws + WS_UEXT);
    const int s = f_tid >> 5, l = f_tid & 31, idx = it * 32 + l, b = idx >> 11, g = (idx >> 6) & 31, p = idx & 63;
    const f32x4 co = *(const f32x4*)(CO + (g * 64 + p) * 4); const float ar = co[0], ai = co[1], a16r = co[2], a16i = co[3];
    const size_t c0 = (size_t)g * NCHUNK + b * 256 + s * 16;
    float pr[16], pi[16]; float hr = 0.f, hq = 0.f;
#pragma unroll
    for (int j = 0; j < 16; ++j) { pr[j] = hr; pi[j] = hq; const float sr = SL[(c0 + j) * 128 + p], si = SL[(c0 + j) * 128 + 64 + p];
        const float nr = ar * hr - ai * hq + sr, ni = ar * hq + ai * hr + si; hr = nr; hq = ni; }
    __syncthreads();
    Er[s * 32 + l] = hr; Ei[s * 32 + l] = hq;
    __syncthreads();
    float cr = 0.f, ci = 0.f;
    for (int s2 = 0; s2 < s; ++s2) { const float er = Er[s2 * 32 + l], ei = Ei[s2 * 32 + l]; const float nr = a16r * cr - a16i * ci + er, ni = a16r * ci + a16i * cr + ei; cr = nr; ci = ni; }
#pragma unroll
    for (int j = 0; j < 16; ++j) { const float orr = cr + pr[j], oi = ci + pi[j];
        bf16_t* dst = UX + (c0 + j) * UK + 512 + p; dst[0] = (bf16_t)(cvtpk(orr, 0.f) & 0xffffu); dst[64] = (bf16_t)(cvtpk(oi, 0.f) & 0xffffu);
        const float nr = ar * cr - ai * ci, ni = ar * ci + ai * cr; cr = nr; ci = ni; }
    __syncthreads();
}

__device__ __forceinline__ void final_norm(Frame& F) {
    FRESH_IDS;
    const float* SS = (const float*)(F.ws + WS_SS); const float* gf = F.in[22];
    const int gw = F.vcu * NWAVES + f_wave, NGW = F.G * NWAVES;
    f32x4 gv[4];
#pragma unroll
    for (int j = 0; j < 4; ++j) gv[j] = *((const f32x4*)gf + f_lane + 64 * j);
    for (int m = gw; m < M; m += NGW) {
        float s = (f_lane < 16) ? SS[(size_t)m * 16 + f_lane] : 0.f; s = wave_sum(s);
        const float rs = 1.0f / sqrtf(s * (1.0f / DM) + EPS);
        f32x4* xr = (f32x4*)(F.out + (size_t)m * DM) + f_lane;
#pragma unroll
        for (int j = 0; j < 4; ++j) { f32x4 v = xr[64 * j]; v = v * rs * gv[j]; xr[64 * j] = v; }
    }
}
constexpr int NPH = 13;
struct Args { const float* in[23]; float* out; unsigned char* ws; int ph_lo, ph_hi; };
__global__ void __launch_bounds__(NTHR, 2) mk_fwd(Args args) {
    extern __shared__ __attribute__((aligned(16))) unsigned char lds[];
    Frame F;
    F.lds = (LAS unsigned char*)lds;
    F.G = gridDim.x; { const int bx = blockIdx.x; F.vcu = (F.G % 8 == 0) ? (bx % 8) * (F.G / 8) + bx / 8 : bx; }
    F.ws = args.ws; F.out = args.out;
#define CP(i) F.in[i] = args.in[i];
    CP(0) CP(1) CP(2) CP(3) CP(4) CP(5) CP(6) CP(7) CP(8) CP(9) CP(10) CP(11) CP(12) CP(13) CP(14) CP(15) CP(16) CP(17) CP(18) CP(19) CP(20) CP(21) CP(22)
#undef CP
    for (int u = threadIdx.x; u < (LDS_BYTES - LDSCTL_OFF) / 4; u += NTHR) ((LAS unsigned*)(F.lds + LDSCTL_OFF))[u] = 0u;
    __syncthreads();
    volatile LAS unsigned* MISC = (volatile LAS unsigned*)(F.lds + MISC_OFF);
    XcdBarrier bar = xcd_barrier_post((unsigned*)(F.ws + WS_CTL) + CW_BAR, MISC + 8);
    const int lo = args.ph_lo, hi = args.ph_hi, bx = (int)blockIdx.x;
    unsigned char* ws = F.ws;
    float* SS = (float*)(ws + WS_SS);
#ifndef REPMASK
#define REPMASK 0
#endif
#define IN(k) (lo <= (k) && (k) < hi)
#define REPS(k) (((REPMASK >> (k)) & 1) ? 2 : 1)
#define REPBAR(k, r) do { if ((r) + 1 < REPS(k)) xcd_barrier(bar); } while (0)
#define SEAM(k) do { if (IN(k) && IN((k) + 1)) xcd_barrier(bar); } while (0)
#define RUN_GEMM(g, S, E) pg8::gemm_phase<true, true>(F.lds, g, S, E)

    if (IN(0)) for (int rep_ = 0; rep_ < REPS(0); ++rep_) { p0_prologue(F); REPBAR(0, rep_); } SEAM(0);

    if (IN(1)) for (int rep_ = 0; rep_ < REPS(1); ++rep_) {
        pg8::Gemm g{(const bf16_t*)(ws + WS_R1), (const bf16_t*)(ws + WS_WGU1), DM, DM, DM, 0, 0}; pg8::Order S; S.init(M / 256, 2 * DFF / 256, 1, F.G, bx);
        pg8::Epi E{}; E.mode = pg8::EP_SWIGLU; E.perm = true; E.ss = SS; E.O = (bf16_t*)(ws + WS_ACT);
        RUN_GEMM(g, S, E);
        REPBAR(1, rep_);
    } SEAM(1);
    if (IN(2)) for (int rep_ = 0; rep_ < REPS(2); ++rep_) {
        pg8::Gemm g{(const bf16_t*)(ws + WS_ACT), (const bf16_t*)(ws + WS_WD1), DFF, DFF, DFF, 0, 0}; pg8::Order S; S.init(M / 256, DM / 256, 1, F.G, bx);
        pg8::Epi E{}; E.mode = pg8::EP_RESID; E.perm = false; E.R = F.in[0]; E.out = F.out; E.xb = (bf16_t*)(ws + WS_R1); E.ss_out = SS; E.alpha = 0.5f;
        RUN_GEMM(g, S, E);
        REPBAR(2, rep_);
    } SEAM(2);
    if (IN(3)) for (int rep_ = 0; rep_ < REPS(3); ++rep_) {
        pg8::Gemm g{(const bf16_t*)(ws + WS_R1), (const bf16_t*)(ws + WS_WIN), DM, DM, DM, 0, 0}; pg8::Order S; S.init(M / 256, 2048 / 256, 1, F.G, bx);
        pg8::Epi E{}; E.mode = pg8::EP_PROJ; E.perm = true; E.ss = SS; E.Q = (bf16_t*)(ws + WS_Q); E.Kimg = (bf16_t*)(ws + WS_K); E.Vimg = (bf16_t*)(ws + WS_V); E.uext = (bf16_t*)(ws + WS_UEXT); E.kmp = (float*)(ws + WS_KMP);
        RUN_GEMM(g, S, E);
        REPBAR(3, rep_);
    } SEAM(3);
    if (IN(4)) for (int rep_ = 0; rep_ < REPS(4); ++rep_) {
        a1_topk(F);
        for (int it = F.vcu; it < 256; it += F.G) tv_expand_item(F, it >> 3, it & 7);
        pg8::Gemm g{(const bf16_t*)(ws + WS_UEXT), (const bf16_t*)(ws + WS_WLOC), UK, 512, 512, (size_t)NCHUNK * UK * 2, (size_t)256 * 512 * 2}; pg8::Order S; S.init(2, 1, 32, F.G, bx);
        pg8::Epi E{}; E.mode = pg8::EP_SLOC; E.perm = false; E.sloc = (float*)(ws + WS_SLOC);
        RUN_GEMM(g, S, E);
        REPBAR(4, rep_);
    } SEAM(4);
    if (IN(5)) for (int rep_ = 0; rep_ < REPS(5); ++rep_) {
        for (int it = F.vcu; it < 128; it += F.G) scan_item(F, it);
        a2_gathered(F, 0);
        REPBAR(5, rep_);
    } SEAM(5);
    if (IN(6)) for (int rep_ = 0; rep_ < REPS(6); ++rep_) {
        { pg8::Gemm g{(const bf16_t*)(ws + WS_UEXT), (const bf16_t*)(ws + WS_TV), UK, UK, UK, (size_t)NCHUNK * UK * 2, (size_t)512 * UK * 2}; pg8::Order S; S.init(2, 2, 32, F.G, bx);
          pg8::Epi E{}; E.mode = pg8::EP_Y; E.perm = true; E.O = (bf16_t*)(ws + WS_GY); E.uext = (bf16_t*)(ws + WS_UEXT); E.dsk = F.in[15];
          RUN_GEMM(g, S, E); }
        if (F.G == 256) { if (bx < 128) a3_own_item(F, bx, rep_ + 1 == REPS(6)); else { for (int k = 0; k < 3; ++k) a3_own_item(F, 128 + (bx - 128) * 3 + k, rep_ + 1 == REPS(6)); } }
        else { for (int it = bx; it < 512; it += F.G) a3_own_item(F, it, rep_ + 1 == REPS(6)); }
        REPBAR(6, rep_);
    } SEAM(6);
    if (IN(7)) for (int rep_ = 0; rep_ < REPS(7); ++rep_) {
        { pg8::Gemm g{(const bf16_t*)(ws + WS_Q), (const bf16_t*)(ws + WS_WAU), AW, AW, AW, 0, 0}; pg8::Order S; S.init(M / 256, DM / 256, 1, F.G, bx);
          pg8::Epi E{}; E.mode = pg8::EP_BF16; E.perm = true; E.O = (bf16_t*)(ws + WS_AUP);
          RUN_GEMM(g, S, E); }
        { pg8::Gemm g{(const bf16_t*)(ws + WS_R1), (const bf16_t*)(ws + WS_WIN) + (size_t)2048 * DM, DM, DM, DM, 0, 0}; pg8::Order S; S.init(M / 256, 2048 / 256, 1, F.G, bx);
          pg8::Epi E{}; E.mode = pg8::EP_GATES; E.perm = true; E.ss = SS; E.O = (bf16_t*)(ws + WS_SGA); E.O2 = (bf16_t*)(ws + WS_SGS);
          RUN_GEMM(g, S, E); }
        REPBAR(7, rep_);
    } SEAM(7);
    if (IN(8)) for (int rep_ = 0; rep_ < REPS(8); ++rep_) {
        pg8::Gemm g{(const bf16_t*)(ws + WS_GY), (const bf16_t*)(ws + WS_WGLU), SW, SW, SW, 0, 0}; pg8::Order S; S.init(M / 256, 2048 / 256, 1, F.G, bx);
        pg8::Epi E{}; E.mode = pg8::EP_MERGE; E.perm = true; E.O = (bf16_t*)(ws + WS_R1); E.aup = (const bf16_t*)(ws + WS_AUP); E.sga = (const bf16_t*)(ws + WS_SGA); E.sgs = (const bf16_t*)(ws + WS_SGS);
        RUN_GEMM(g, S, E);
        REPBAR(8, rep_);
    } SEAM(8);
    if (IN(9)) for (int rep_ = 0; rep_ < REPS(9); ++rep_) {
        pg8::Gemm g{(const bf16_t*)(ws + WS_R1), (const bf16_t*)(ws + WS_WOUT), DM, DM, DM, 0, 0}; pg8::Order S; S.init(M / 256, DM / 256, 1, F.G, bx);
        pg8::Epi E{}; E.mode = pg8::EP_RESID; E.perm = false; E.R = F.out; E.out = F.out; E.xb = (bf16_t*)(ws + WS_X2B); E.ss_out = SS; E.alpha = 1.0f;
        RUN_GEMM(g, S, E);
        REPBAR(9, rep_);
    } SEAM(9);
    if (IN(10)) for (int rep_ = 0; rep_ < REPS(10); ++rep_) {
        pg8::Gemm g{(const bf16_t*)(ws + WS_X2B), (const bf16_t*)(ws + WS_WGU2), DM, DM, DM, 0, 0}; pg8::Order S; S.init(M / 256, 2 * DFF / 256, 1, F.G, bx);
        pg8::Epi E{}; E.mode = pg8::EP_SWIGLU; E.perm = true; E.ss = SS; E.O = (bf16_t*)(ws + WS_ACT);
        RUN_GEMM(g, S, E);
        REPBAR(10, rep_);
    } SEAM(10);
    if (IN(11)) for (int rep_ = 0; rep_ < REPS(11); ++rep_) {
        pg8::Gemm g{(const bf16_t*)(ws + WS_ACT), (const bf16_t*)(ws + WS_WD2), DFF, DFF, DFF, 0, 0}; pg8::Order S; S.init(M / 256, DM / 256, 1, F.G, bx);
        pg8::Epi E{}; E.mode = pg8::EP_RESID; E.perm = false; E.R = F.out; E.out = F.out; E.xb = nullptr; E.ss_out = SS; E.alpha = 0.5f;
        RUN_GEMM(g, S, E);
        REPBAR(11, rep_);
    } SEAM(11);
    if (IN(12)) { final_norm(F); }
#undef IN
#undef SEAM
#undef RUN_GEMM
}

#ifndef HYB
#define HYB 0
#endif
#if HYB

__global__ void bf2f_k(const bf16_t* in, float* out, size_t n) { size_t i = (size_t)blockIdx.x * blockDim.x + threadIdx.x; if (i < n) out[i] = __uint_as_float((unsigned)in[i] << 16); }
static void v1gemm(hipStream_t st, const float* A, int lda, const float* B, int ldb, float* C, int ldc, int Mr, int N, int K) { sgemm_k<0><<<dim3(N / 128, Mr / 128), 256, 0, st>>>(A, lda, B, ldb, C, ldc, K, nullptr, 0, 0.f); }
static void v1gemm_res(hipStream_t st, const float* A, int lda, const float* B, int ldb, float* C, int ldc, int Mr, int N, int K, const float* R, int ldr, float alpha) { sgemm_k<1><<<dim3(N / 128, Mr / 128), 256, 0, st>>>(A, lda, B, ldb, C, ldc, K, R, ldr, alpha); }
#endif
#ifndef USE_MK_ATTN
#define USE_MK_ATTN 1
#endif
#ifndef USE_MK_GY
#define USE_MK_GY 1
#endif

extern "C" void kernel_launch(void* const* d_in, const int* in_sizes, int n_in, void* d_out, int out_size, void* d_ws, size_t ws_size, hipStream_t stream) {
    static int grid = 0;
    if (grid == 0) {
        if (n_in != 23 || in_sizes[0] != M * DM || out_size != M * DM || ws_size < WS_END) { fprintf(stderr, "kernel_launch: unexpected shapes (n_in %d in0 %d out %d ws %zu)\n", n_in, n_in > 0 ? in_sizes[0] : -1, out_size, ws_size); grid = -1; return; }
        int dev = 0, cus = 0, per_cu = 0;
        if (hipGetDevice(&dev) != hipSuccess || hipDeviceGetAttribute(&cus, hipDeviceAttributeMultiprocessorCount, dev) != hipSuccess) { grid = -1; return; }
        if (hipFuncSetAttribute((const void*)mk_fwd, hipFuncAttributeMaxDynamicSharedMemorySize, LDS_BYTES) != hipSuccess) { fprintf(stderr, "kernel_launch: hipFuncSetAttribute failed\n"); grid = -1; return; }
        if (hipOccupancyMaxActiveBlocksPerMultiprocessor(&per_cu, (const void*)mk_fwd, NTHR, LDS_BYTES) != hipSuccess || per_cu < 1) fprintf(stderr, "kernel_launch: occupancy query says %d blocks/CU\n", per_cu);
        (void)hipGetLastError();
        grid = cus;
    }
    if (grid < 0) return;
    (void)hipMemsetAsync((char*)d_ws + WS_CTL, 0, CTL_ZERO_BYTES, stream);
    Args a{};
    for (int i = 0; i < 23; ++i) a.in[i] = (const float*)d_in[i];
    a.out = (float*)d_out; a.ws = (unsigned char*)d_ws;
    a.ph_lo = 0;
    a.ph_hi = (HYB == 0) ? NPH : (HYB == 1) ? 3 : (HYB == 2) ? 7 : 10;
    hipLaunchKernelGGL(mk_fwd, dim3(grid), dim3(NTHR), LDS_BYTES, stream, a);
#if HYB
    const float* x = (const float*)d_in[0]; (void)x;
    const float* nm = (const float*)d_in[5]; const float* win = (const float*)d_in[6]; const float* wau = (const float*)d_in[7];
    const float *lre = (const float*)d_in[8], *lim = (const float*)d_in[9], *ldt = (const float*)d_in[10];
    const float *bre = (const float*)d_in[11], *bim = (const float*)d_in[12], *cre = (const float*)d_in[13], *cim = (const float*)d_in[14], *dsk = (const float*)d_in[15];
    const float* wglu = (const float*)d_in[16]; const float* wout = (const float*)d_in[17]; const float* n2 = (const float*)d_in[18];
    const float *wg2 = (const float*)d_in[19], *wu2 = (const float*)d_in[20], *wd2 = (const float*)d_in[21]; const float* nf = (const float*)d_in[22];
    float* out = (float*)d_out; float* ws = (float*)d_ws;
    size_t off = 0; auto take = [&](size_t n) { float* p = ws + off; off += (n + 63) & ~(size_t)63; return p; };
    float* hc = take((size_t)CH * 1024); float* G = take((size_t)CH * DFF); float* U = take((size_t)CH * DFF);
    float* qc = take((size_t)CH * AW); float* ac = take((size_t)CH * AW); float* aup = take((size_t)CH * 1024);
    float* ga = take((size_t)CH * 1024); float* gs = take((size_t)CH * 1024); float* glu = take((size_t)CH * 2048); float* mg = take((size_t)CH * 1024);
    float* kmean = take(BATCH * NH * NBLK * HD); float* abr = take(2048); float* abi = take(2048); float* bbr = take(2048 * 16); float* bbi = take(2048 * 16);
    if (off * 4 > 110 * MiB) { fprintf(stderr, "hybrid scratch too large\n"); return; }
    float* kb = (float*)((char*)d_ws + 126 * MiB); float* vb = kb + (size_t)MTOK * AW; float* ub = vb + (size_t)MTOK * AW;
    const size_t nact = (size_t)CH * DFF;
#if HYB <= 2
    for (int r0 = 0; r0 < MTOK; r0 += CH) {
        float* x1 = out + (size_t)r0 * 1024;
        rmsnorm_k<<<CH, 256, 0, stream>>>(x1, nm, hc);
        v1gemm(stream, hc, 1024, win + 512, INW, kb + (size_t)r0 * AW, AW, CH, AW, 1024);
        v1gemm(stream, hc, 1024, win + 1024, INW, vb + (size_t)r0 * AW, AW, CH, AW, 1024);
        v1gemm(stream, hc, 1024, win + 1536, INW, ub + (size_t)r0 * AW, AW, CH, AW, 1024);
    }
    kmean_k<<<dim3(NBLK, NH, BATCH), 64, 0, stream>>>(kb, kmean);
    ssm_prep_k<<<8, 256, 0, stream>>>(lre, lim, ldt, bre, bim, abr, abi, bbr, bbi);
    ssm_scan_k<<<dim3(32, BATCH), 64, 0, stream>>>(ub, abr, abi, bbr, bbi, cre, cim, dsk);
#endif
    for (int r0 = 0; r0 < MTOK; r0 += CH) {
        float* x1 = out + (size_t)r0 * 1024;
#if HYB <= 2
        rmsnorm_k<<<CH, 256, 0, stream>>>(x1, nm, hc);
        v1gemm(stream, hc, 1024, win, INW, qc, AW, CH, AW, 1024);
        v1gemm(stream, hc, 1024, win + 2048, INW, ga, 1024, CH, 1024, 1024);
        v1gemm(stream, hc, 1024, win + 3072, INW, gs, 1024, CH, 1024, 1024);
        if (HYB == 2 && USE_MK_ATTN) bf2f_k<<<(CH * AW + 255) / 256, 256, 0, stream>>>((const bf16_t*)((char*)d_ws + WS_Q) + (size_t)r0 * AW, ac, (size_t)CH * AW);
        else attn_naive_k<<<dim3(CH / 4, NH), 256, 0, stream>>>(qc, r0, kb, vb, kmean, ac);
        v1gemm(stream, ac, AW, wau, 1024, aup, 1024, CH, 1024, AW);
        if (HYB == 2 && USE_MK_GY) bf2f_k<<<(CH * SW + 255) / 256, 256, 0, stream>>>((const bf16_t*)((char*)d_ws + WS_GY) + (size_t)r0 * SW, qc, (size_t)CH * SW);
        else gelu_k<<<(CH * SW + 255) / 256, 256, 0, stream>>>(ub + (size_t)r0 * SW, qc, (size_t)CH * SW);
        v1gemm(stream, qc, SW, wglu, 2048, glu, 2048, CH, 2048, SW);
        merge_k<<<(CH * 1024 + 255) / 256, 256, 0, stream>>>(ga, gs, aup, glu, mg, CH);
        v1gemm_res(stream, mg, 1024, wout, 1024, x1, 1024, CH, 1024, 1024, x1, 1024, 1.0f);
#endif
        rmsnorm_k<<<CH, 256, 0, stream>>>(x1, n2, hc);
        v1gemm(stream, hc, 1024, wg2, DFF, G, DFF, CH, DFF, 1024);
        v1gemm(stream, hc, 1024, wu2, DFF, U, DFF, CH, DFF, 1024);
        swiglu_k<<<(unsigned)((nact + 255) / 256), 256, 0, stream>>>(G, U, nact);
        v1gemm_res(stream, G, DFF, wd2, 1024, x1, 1024, CH, 1024, DFF, x1, 1024, 0.5f);
        rmsnorm_k<<<CH, 256, 0, stream>>>(x1, nf, x1);
    }
#endif
}
```
